# Optimizing an MI355X kernel written in HIP

```python
import math
import jax, jax.numpy as jnp
from jax import lax
import numpy as np

D_MODEL = 1024
BATCH = 8
SEQ = 2048
DEPTH = 4

N_A_LAYERS = DEPTH // 2
N_B_LAYERS = DEPTH - N_A_LAYERS
CONV_WIDTH = 31
N_HEADS = 8
HEAD_DIM = D_MODEL // N_HEADS // 2
V_DIM = 2 * HEAD_DIM
QK_WIDTH = N_HEADS * 2 * HEAD_DIM
V_WIDTH = N_HEADS * V_DIM
D_FF = -(-(8 * D_MODEL) // (3 * 256)) * 256
Q_BLOCK = 128
EPS = 1e-6

kernel_name = "yoco_conformer_diffattn_alibi"


def rmsnorm(x, g):
    x32 = x.astype(jnp.float32)
    y = x32 * lax.rsqrt(jnp.mean(x32 * x32, axis=-1, keepdims=True) + EPS)
    return (y * g.astype(jnp.float32)).astype(x.dtype)


def layernorm(x, g, b):
    x32 = x.astype(jnp.float32)
    mu = jnp.mean(x32, axis=-1, keepdims=True)
    xc = x32 - mu
    y = xc * lax.rsqrt(jnp.mean(xc * xc, axis=-1, keepdims=True) + EPS)
    return (y * g.astype(jnp.float32) + b.astype(jnp.float32)).astype(x.dtype)


def alibi_slopes():
    return jnp.asarray((2.0 ** (-8.0 * np.arange(1, N_HEADS + 1) / N_HEADS)).astype(np.float32))


def conformer_conv(h, pw1_w, pw1_b, dw_w, dw_b, ln_g, ln_b, pw2_w, pw2_b):
    u = h @ pw1_w + pw1_b
    a, gate = jnp.split(u, 2, axis=-1)
    u = a * jax.nn.sigmoid(gate)
    u = lax.conv_general_dilated(
        u, dw_w[:, None, :].astype(u.dtype), window_strides=(1,),
        padding=((CONV_WIDTH - 1, 0),),
        dimension_numbers=("NWC", "WIO", "NWC"),
        feature_group_count=D_MODEL) + dw_b
    u = jax.nn.silu(layernorm(u, ln_g, ln_b))
    return u @ pw2_w + pw2_b


def diff_attention(h, k, v, w_q, lam_q1, lam_k1, lam_q2, lam_k2, subln_g, w_o, lambda_init):
    B, S, _ = h.shape
    q = (h @ w_q).reshape(B, S, N_HEADS, 2, HEAD_DIM)
    lam = (jnp.exp(jnp.sum(lam_q1.astype(jnp.float32) * lam_k1.astype(jnp.float32)))
           - jnp.exp(jnp.sum(lam_q2.astype(jnp.float32) * lam_k2.astype(jnp.float32)))
           + lambda_init)
    slopes = alibi_slopes()
    scale = HEAD_DIM ** -0.5
    outs = []
    for i in range(S // Q_BLOCK):
        end = (i + 1) * Q_BLOCK
        q_blk = q[:, i * Q_BLOCK:end]
        k_pre = k[:, :end]
        v_pre = v[:, :end]
        s = jnp.einsum("bqhcd,bkhcd->bhcqk", q_blk, k_pre,
                       preferred_element_type=jnp.float32) * scale
        t_pos = i * Q_BLOCK + jnp.arange(Q_BLOCK)
        s_pos = jnp.arange(end)
        dist = (t_pos[:, None] - s_pos[None, :]).astype(jnp.float32)
        bias = jnp.where(dist >= 0, -slopes[:, None, None] * dist, -jnp.inf)
        p = jax.nn.softmax(s + bias[None, :, None], axis=-1)
        attn = p[:, :, 0] - lam * p[:, :, 1]
        outs.append(jnp.einsum("bhqk,bkhe->bqhe", attn.astype(v.dtype), v_pre))
    o = jnp.concatenate(outs, axis=1)
    o = rmsnorm(o, subln_g) * (1.0 - lambda_init)
    return o.reshape(B, S, V_WIDTH) @ w_o


def swiglu(h, w1, w3, w2):
    return (jax.nn.silu(h @ w1) * (h @ w3)) @ w2


def setup_inputs(seed: int = 0) -> dict:
    key = jax.random.key(seed)
    ks = iter(jax.random.split(key, 32))
    f32 = jnp.float32

    def nrm(shape, scale):
        return jax.random.normal(next(ks), shape, f32) * scale

    def gain(shape):
        return 1.0 + nrm(shape, 0.02)

    D = D_MODEL
    return {
        "x": nrm((BATCH, SEQ, D), 1.0),
        "conv_norm_g": gain((N_A_LAYERS, D)),
        "pw1_w": nrm((N_A_LAYERS, D, 2 * D), D ** -0.5),
        "pw1_b": nrm((N_A_LAYERS, 2 * D), 0.02),
        "dw_w": nrm((N_A_LAYERS, CONV_WIDTH, D), CONV_WIDTH ** -0.5),
        "dw_b": nrm((N_A_LAYERS, D), 0.02),
        "conv_ln_g": gain((N_A_LAYERS, D)),
        "conv_ln_b": nrm((N_A_LAYERS, D), 0.02),
        "pw2_w": nrm((N_A_LAYERS, D, D), D ** -0.5),
        "pw2_b": nrm((N_A_LAYERS, D), 0.02),
        "kv_norm_g": gain((D,)),
        "w_k": nrm((D, QK_WIDTH), D ** -0.5),
        "w_v": nrm((D, V_WIDTH), D ** -0.5),
        "attn_norm_g": gain((N_B_LAYERS, D)),
        "w_q": nrm((N_B_LAYERS, D, QK_WIDTH), D ** -0.5),
        "lambda_q1": nrm((N_B_LAYERS, HEAD_DIM), 0.1),
        "lambda_k1": nrm((N_B_LAYERS, HEAD_DIM), 0.1),
        "lambda_q2": nrm((N_B_LAYERS, HEAD_DIM), 0.1),
        "lambda_k2": nrm((N_B_LAYERS, HEAD_DIM), 0.1),
        "subln_g": gain((N_B_LAYERS, V_DIM)),
        "w_o": nrm((N_B_LAYERS, V_WIDTH, D), V_WIDTH ** -0.5),
        "ffn_norm_g": gain((DEPTH, D)),
        "ffn_w1": nrm((DEPTH, D, D_FF), D ** -0.5),
        "ffn_w3": nrm((DEPTH, D, D_FF), D ** -0.5),
        "ffn_w2": nrm((DEPTH, D_FF, D), D_FF ** -0.5),
        "final_norm_g": gain((D,)),
    }


def reference(x, conv_norm_g, pw1_w, pw1_b, dw_w, dw_b, conv_ln_g, conv_ln_b, pw2_w, pw2_b,
              kv_norm_g, w_k, w_v, attn_norm_g, w_q, lambda_q1, lambda_k1, lambda_q2, lambda_k2,
              subln_g, w_o, ffn_norm_g, ffn_w1, ffn_w3, ffn_w2, final_norm_g):
    B, S, _ = x.shape
    k = None
    v = None
    for layer in range(DEPTH):
        if layer < N_A_LAYERS:
            x = x + conformer_conv(rmsnorm(x, conv_norm_g[layer]), pw1_w[layer], pw1_b[layer],
                                   dw_w[layer], dw_b[layer], conv_ln_g[layer], conv_ln_b[layer],
                                   pw2_w[layer], pw2_b[layer])
        else:
            j = layer - N_A_LAYERS
            lambda_init = 0.8 - 0.6 * math.exp(-0.3 * layer)
            x = x + diff_attention(rmsnorm(x, attn_norm_g[j]), k, v, w_q[j],
                                   lambda_q1[j], lambda_k1[j], lambda_q2[j], lambda_k2[j],
                                   subln_g[j], w_o[j], lambda_init)
        x = x + swiglu(rmsnorm(x, ffn_norm_g[layer]), ffn_w1[layer], ffn_w3[layer], ffn_w2[layer])
        if layer == N_A_LAYERS - 1:
            kv_in = rmsnorm(x, kv_norm_g)
            k = (kv_in @ w_k).reshape(B, S, N_HEADS, 2, HEAD_DIM)
            v = (kv_in @ w_v).reshape(B, S, N_HEADS, V_DIM)
    return rmsnorm(x, final_norm_g)
```

```cpp
#define MK_ONE_LAUNCH 1
#include <hip/hip_runtime.h>
#include <cstdio>
#include <cstdint>
#include <cmath>
namespace pg8 {
#define PG8_LAS __attribute__((address_space(3)))
typedef unsigned short bf16_t;
typedef short bf16x8 __attribute__((ext_vector_type(8)));
typedef float f32x4 __attribute__((ext_vector_type(4)));
typedef unsigned u32x4 __attribute__((ext_vector_type(4)));
constexpr int BM = 256, BK = 64, HALF = 128, HTB = HALF * BK * 2  , STAGE_BYTES = 8 * HTB, NXCD = 8, WGM = 8;

__host__ __device__ __forceinline__ int lds_byte(int r, int c) { const int st = (r >> 4) * 2 + (c >> 5), rr = r & 15, cc = c & 31, ob = rr * 64 + cc * 2; return st * 1024 + (ob ^ (((ob >> 9) & 1) << 5)); }
__host__ __device__ __forceinline__ void stage_rc(int b, int& R, int& C) { const int st = b / 1024, sb = b % 1024, swz = sb ^ (((sb >> 9) & 1) << 5); R = (st >> 1) * 16 + swz / 64; C = (st & 1) * 32 + (swz % 64) / 2; }
__host__ __device__ __forceinline__ int perm32(int rho) { const int n = rho >> 4, i = rho & 15; return 8 * (i >> 2) + 4 * n + (i & 3); }

struct Unit { int pm, pn; };
struct Gemm { const bf16_t* A; const bf16_t* Bt; int M, N, K; };

struct StaticOrder {
    int nM, nN, nwg, G, c;
    __host__ __device__ void init(int M, int N, int G_, int c_) { nM = M / BM; nN = N / BM; nwg = nM * nN; G = G_; c = c_; }
    __host__ __device__ bool next(int i, Unit& u) const {
        const long L = (long)i * G + c; if (L >= nwg) return false;
        int wgid = (int)L; { const int q = nwg / NXCD, r = nwg % NXCD, xcd = wgid % NXCD, off = wgid / NXCD; wgid = (xcd < r ? xcd * (q + 1) : r * (q + 1) + (xcd - r) * q) + off; }
        const int nig = WGM * nN, gid = wgid / nig, fm = gid * WGM, gsz = (nM - fm) < WGM ? (nM - fm) : WGM;
        u.pm = fm + ((wgid % nig) % gsz); u.pn = (wgid % nig) / gsz; return true;
    }
    __device__ __forceinline__ void a_ready(const Unit&) const {}
    __device__ __forceinline__ void done(const Unit&) const {}
};

__device__ __forceinline__ unsigned cvt_pk_bf16(float lo, float hi) { unsigned r; asm volatile("v_cvt_pk_bf16_f32 %0, %1, %2" : "=v"(r) : "v"(lo), "v"(hi)); return r; }
typedef unsigned u32x2 __attribute__((ext_vector_type(2)));
constexpr float NORM_EPS = 1e-6f;
__device__ __forceinline__ float row_rstd(const float* ssq, int row) { const f32x4 s = *(const f32x4*)(ssq + (size_t)row * 4); return __builtin_amdgcn_rsqf(((s[0] + s[1]) + (s[2] + s[3])) * (1.0f / 1024.0f) + NORM_EPS); }
__device__ __forceinline__ float sigmoidf_(float x) { return __builtin_amdgcn_rcpf(1.0f + __builtin_amdgcn_exp2f(-1.4426950408889634f * x)); }

template <int MODE> struct EpiGate {
    static constexpr bool PERM = true, AFTER_DRAIN = false;
    bf16_t* O; int ldc; const float* ssq; const float* bias;
    __device__ __forceinline__ void operator()(const f32x4 (&acc)[2][2][4][2], const Unit& u, int wr, int wc, int fr, int fq) const {
        const int row0 = u.pm * BM + wr * 64 + fr, ch0 = u.pn * HALF + wc * 32 + 8 * fq;
        f32x4 ba[2], bg[2];
#pragma unroll
        for (int n = 0; n < 2; ++n) {
            if (MODE == 0) { ba[n] = *(const f32x4*)(bias + ch0 + 4 * n); bg[n] = *(const f32x4*)(bias + 1024 + ch0 + 4 * n); }
            else { ba[n] = (f32x4){0.f, 0.f, 0.f, 0.f}; bg[n] = (f32x4){0.f, 0.f, 0.f, 0.f}; } }
        float rsv[2][4];
#pragma unroll
        for (int ai = 0; ai < 2; ++ai)
#pragma unroll
            for (int m = 0; m < 4; ++m) rsv[ai][m] = row_rstd(ssq, row0 + ai * HALF + m * 16);
        asm volatile("" ::: "memory");
#pragma unroll
        for (int ai = 0; ai < 2; ++ai)
#pragma unroll
            for (int m = 0; m < 4; ++m) { const int row = row0 + ai * HALF + m * 16; const float rs = rsv[ai][m];
                u32x4 w;
#pragma unroll
                for (int n = 0; n < 2; ++n) { const f32x4 a = acc[ai][0][m][n] * rs + ba[n], g = acc[ai][1][m][n] * rs + bg[n]; f32x4 y;
#pragma unroll
                    for (int i = 0; i < 4; ++i) y[i] = (MODE == 0) ? a[i] * sigmoidf_(g[i]) : (a[i] * sigmoidf_(a[i])) * g[i];
                    w[2 * n] = cvt_pk_bf16(y[0], y[1]); w[2 * n + 1] = cvt_pk_bf16(y[2], y[3]); }
                *(u32x4*)(O + (size_t)row * ldc + ch0) = w; asm volatile("" ::: "memory"); }
    }
};
template <size_t OFFQ, size_t OFFK, size_t OFFV> struct EpiQKV {
    static constexpr bool PERM = true, AFTER_DRAIN = false;
    unsigned char* ws; const float* ssq; float qscale;
    __device__ __forceinline__ void operator()(const f32x4 (&acc)[2][2][4][2], const Unit& u, int wr, int wc, int fr, int fq) const {
        const int row0 = u.pm * BM + wr * 64 + fr; int colt = u.pn * BM; const int t = colt >> 10; colt &= 1023;
        const size_t boff = (t == 0 ? OFFQ : 0) + (t == 1 ? OFFK : 0) + (t == 2 ? OFFV : 0);
        bf16_t* base = (bf16_t*)(ws + boff); const float sc = (t == 0) ? qscale : 1.0f;
        const int col0 = colt + wc * 32 + 8 * fq;
        float rsv[2][4];
#pragma unroll
        for (int ai = 0; ai < 2; ++ai)
#pragma unroll
            for (int m = 0; m < 4; ++m) rsv[ai][m] = row_rstd(ssq, row0 + ai * HALF + m * 16) * sc;
        asm volatile("" ::: "memory");
#pragma unroll
        for (int ai = 0; ai < 2; ++ai)
#pragma unroll
            for (int m = 0; m < 4; ++m) { const int row = row0 + ai * HALF + m * 16; const float rs = rsv[ai][m]; bf16_t* rowp = base + (size_t)row * 1024 + col0;
#pragma unroll
                for (int bj = 0; bj < 2; ++bj) { const f32x4 v0 = acc[ai][bj][m][0] * rs, v1 = acc[ai][bj][m][1] * rs; u32x4 w;
                    w.x = cvt_pk_bf16(v0[0], v0[1]); w.y = cvt_pk_bf16(v0[2], v0[3]); w.z = cvt_pk_bf16(v1[0], v1[1]); w.w = cvt_pk_bf16(v1[2], v1[3]);
                    *(u32x4*)(rowp + bj * HALF) = w; } asm volatile("" ::: "memory"); }
    }
};
struct EpiRes {
    static constexpr bool PERM = false, AFTER_DRAIN = true;
    const float* base; float* out; bf16_t* xb; float* ssq; const float* bias;
    __device__ __forceinline__ void fused(f32x4 (&acc)[2][2][4][2], const Unit& u, int wr, int wc, int fr, int fq, PG8_LAS unsigned char* lds, int wid, int lane) const {
        const int col0 = u.pn * BM + wc * 32 + 4 * fq;
        PG8_LAS float* P = (PG8_LAS float*)lds;
        f32x4 bv[2][2];
#pragma unroll
        for (int bj = 0; bj < 2; ++bj)
#pragma unroll
            for (int n = 0; n < 2; ++n) bv[bj][n] = bias ? *(const f32x4*)(bias + col0 + bj * HALF + n * 16) : (f32x4){0.f, 0.f, 0.f, 0.f};
#pragma unroll
        for (int ai = 0; ai < 2; ++ai)
#pragma unroll
            for (int m = 0; m < 4; ++m) { const int r = ai * HALF + wr * 64 + m * 16 + fr; const size_t off = (size_t)(u.pm * BM + r) * 1024 + col0; float ss = 0.f;
#pragma unroll
                for (int bj = 0; bj < 2; ++bj)
#pragma unroll
                    for (int n = 0; n < 2; ++n) { const size_t c = off + bj * HALF + n * 16; const f32x4 bs = *(const f32x4*)(base + c); const f32x4 o = bs + acc[ai][bj][m][n] + bv[bj][n];
                        *(f32x4*)(out + c) = o; u32x2 w; w.x = cvt_pk_bf16(o[0], o[1]); w.y = cvt_pk_bf16(o[2], o[3]); *(u32x2*)(xb + c) = w;
                        ss += (o[0] * o[0] + o[1] * o[1]) + (o[2] * o[2] + o[3] * o[3]); }
                ss += __shfl_xor(ss, 16); ss += __shfl_xor(ss, 32);
                if (fq == 0) P[r * 4 + wc] = ss;
                if (m & 1) asm volatile("" ::: "memory"); }
        asm volatile("s_waitcnt lgkmcnt(0)" ::: "memory"); __builtin_amdgcn_s_barrier(); asm volatile("" ::: "memory");
        const int tid = wid * 64 + lane;
        if (tid < 256) { const PG8_LAS f32x4* P4 = (const PG8_LAS f32x4*)lds; const f32x4 p = P4[tid]; ssq[(size_t)(u.pm * BM + tid) * 4 + u.pn] = (p[0] + p[1]) + (p[2] + p[3]); }
    }
};

template <class Epi, class Sched, bool ALIGN_EPI = false, bool SP2 = false>
__device__ __forceinline__ void gemm_phase(PG8_LAS unsigned char* lds, const Gemm g, const Sched& S, const Epi& E) {
    int tid_ = threadIdx.x; asm volatile("" : "+v"(tid_));
    const int tid = tid_, wid = __builtin_amdgcn_readfirstlane(tid >> 6), lane = tid & 63, wr = wid >> 2, wc = wid & 3, fr = lane & 15, fq = lane >> 4;
    const int K = g.K, nt = K / BK;
    unsigned voffA[2], voffB[2];
#pragma unroll
    for (int i = 0; i < 2; ++i) { int R, C; stage_rc(tid * 16 + i * 8192, R, C); const int Rb = Epi::PERM ? ((R & ~31) + perm32(R & 31)) : R;
        voffA[i] = (unsigned)(R * K + C) * 2u; voffB[i] = (unsigned)(Rb * K + C) * 2u; }
    const size_t kstep = (size_t)(BK * 2);
    const size_t hstep = (size_t)HALF * K * 2;
    const size_t tstep = 2 * hstep;
    const unsigned ldsw = (unsigned)wid * 1024u;
    const int aoff = lds_byte(wr * 64 + fr, fq * 8), boff = lds_byte(wc * 32 + fr, fq * 8);
#define PG8_SA(b, h) (((b) * 2 + (h)) * HTB)
#define PG8_SB(b, h) ((4 + (b) * 2 + (h)) * HTB)
#define PG8_STAGE(bufoff, gbase, voff) do { _Pragma("unroll") for (int _i = 0; _i < 2; ++_i) \
        __builtin_amdgcn_global_load_lds((const unsigned*)((const char*)(gbase) + (voff)[_i]), (PG8_LAS unsigned*)(lds + (bufoff) + ldsw + _i * 8192), 16, 0, 0); } while (0)
#define PG8_LDA(dst, b, h) do { _Pragma("unroll") for (int m = 0; m < 4; ++m) _Pragma("unroll") for (int k = 0; k < 2; ++k) dst[m][k] = *(const PG8_LAS bf16x8*)(lds + PG8_SA(b, h) + aoff + m * 2048 + k * 1024); } while (0)
#define PG8_LDB(dst, b, h) do { _Pragma("unroll") for (int n = 0; n < 2; ++n) _Pragma("unroll") for (int k = 0; k < 2; ++k) dst[n][k] = *(const PG8_LAS bf16x8*)(lds + PG8_SB(b, h) + boff + n * 2048 + k * 1024); } while (0)
#define PG8_MMA(ai, bj, At, Bt) do { __builtin_amdgcn_s_setprio(1); _Pragma("unroll") for (int m = 0; m < 4; ++m) _Pragma("unroll") for (int n = 0; n < 2; ++n) _Pragma("unroll") for (int k = 0; k < 2; ++k) \
        acc[ai][bj][m][n] = __builtin_amdgcn_mfma_f32_16x16x32_bf16(Bt[n][k], At[m][k], acc[ai][bj][m][n], 0, 0, 0); __builtin_amdgcn_s_setprio(0); } while (0)
#define PG8_WAIT_V(n) asm volatile("s_waitcnt vmcnt(" #n ")" ::: "memory")
#define PG8_WAIT_L(n) asm volatile("s_waitcnt lgkmcnt(" #n ")" ::: "memory")
#define PG8_BAR __builtin_amdgcn_s_barrier()
#define PG8_SCHED __builtin_amdgcn_sched_barrier(0)
    Unit cur, nxt; int ui = 0;
    if (!S.next(0, cur)) return;
    f32x4 acc[2][2][4][2];
#pragma unroll
    for (int a = 0; a < 2; ++a)
#pragma unroll
        for (int b = 0; b < 2; ++b)
#pragma unroll
            for (int m = 0; m < 4; ++m)
#pragma unroll
                for (int n = 0; n < 2; ++n) acc[a][b][m][n] = (f32x4){0.f, 0.f, 0.f, 0.f};
    bf16x8 At[4][2], B0[2][2], B1[2][2];
    const char* cA = (const char*)g.A + (size_t)cur.pm * tstep; const char* cB = (const char*)g.Bt + (size_t)cur.pn * tstep;
    S.a_ready(cur);
    if constexpr (SP2) {
        PG8_STAGE(PG8_SB(0, 0), cB, voffB); PG8_STAGE(PG8_SB(0, 1), cB + hstep, voffB); PG8_STAGE(PG8_SA(0, 0), cA, voffA); PG8_STAGE(PG8_SA(0, 1), cA + hstep, voffA);
        if (wr == 1) PG8_BAR;
        PG8_WAIT_V(2); PG8_BAR;
        PG8_STAGE(PG8_SB(1, 0), cB + kstep, voffB); PG8_STAGE(PG8_SA(1, 0), cA + kstep, voffA); PG8_STAGE(PG8_SB(1, 1), cB + hstep + kstep, voffB);
        PG8_WAIT_V(6); PG8_BAR;
    } else {
        PG8_STAGE(PG8_SB(0, 0), cB, voffB); PG8_STAGE(PG8_SA(0, 0), cA, voffA); PG8_STAGE(PG8_SB(0, 1), cB + hstep, voffB); PG8_STAGE(PG8_SA(0, 1), cA + hstep, voffA);
        if (wr == 1) PG8_BAR;
        PG8_WAIT_V(4); PG8_BAR;
        PG8_STAGE(PG8_SB(1, 0), cB + kstep, voffB); PG8_STAGE(PG8_SA(1, 0), cA + kstep, voffA); PG8_STAGE(PG8_SB(1, 1), cB + hstep + kstep, voffB);
        PG8_WAIT_V(6); PG8_BAR;
    }
    for (;;) {
        const bool has_next = S.next(ui + 1, nxt);
        const char* nA = has_next ? (const char*)g.A + (size_t)nxt.pm * tstep : cA; const char* nB = has_next ? (const char*)g.Bt + (size_t)nxt.pn * tstep : cB;
        for (int t = 0; t < nt; t += 2) {
            const bool last = (t == nt - 2);
            const char* a1 = cA + (size_t)(t + 1) * kstep;
            const char* a2 = last ? nA : cA + (size_t)(t + 2) * kstep; const char* b2 = last ? nB : cB + (size_t)(t + 2) * kstep;
            const char* a3 = a2 + kstep; const char* b3 = b2 + kstep;
            if (last && has_next) S.a_ready(nxt);
            if constexpr (SP2) {
            PG8_LDB(B0, 0, 0); PG8_LDB(B1, 0, 1); PG8_SCHED; PG8_LDA(At, 0, 0); PG8_STAGE(PG8_SA(1, 1), a1 + hstep, voffA);
            PG8_WAIT_V(8); PG8_WAIT_L(0); PG8_BAR; PG8_MMA(0, 0, At, B0); PG8_MMA(0, 1, At, B1); PG8_BAR; PG8_SCHED;
            PG8_LDA(At, 0, 1); PG8_STAGE(PG8_SB(0, 0), b2, voffB); PG8_STAGE(PG8_SB(0, 1), b2 + hstep, voffB); PG8_STAGE(PG8_SA(0, 0), a2, voffA);
            PG8_WAIT_V(8); PG8_WAIT_L(0); PG8_BAR; PG8_MMA(1, 0, At, B0); PG8_MMA(1, 1, At, B1); PG8_BAR; PG8_SCHED;
            PG8_LDB(B0, 1, 0); PG8_LDB(B1, 1, 1); PG8_SCHED; PG8_LDA(At, 1, 0); PG8_STAGE(PG8_SA(0, 1), a2 + hstep, voffA);
            PG8_WAIT_V(8); PG8_WAIT_L(0); PG8_BAR; PG8_MMA(0, 0, At, B0); PG8_MMA(0, 1, At, B1); PG8_BAR; PG8_SCHED;
            PG8_LDA(At, 1, 1); PG8_STAGE(PG8_SB(1, 0), b3, voffB); PG8_STAGE(PG8_SB(1, 1), b3 + hstep, voffB); PG8_STAGE(PG8_SA(1, 0), a3, voffA);
            PG8_WAIT_V(8); PG8_WAIT_L(0); PG8_BAR; PG8_MMA(1, 0, At, B0); PG8_MMA(1, 1, At, B1); PG8_BAR; PG8_SCHED;
            } else {
            PG8_LDB(B0, 0, 0); PG8_SCHED; PG8_LDA(At, 0, 0); PG8_STAGE(PG8_SA(1, 1), a1 + hstep, voffA);
            PG8_WAIT_L(8); PG8_BAR; PG8_WAIT_L(0); PG8_MMA(0, 0, At, B0); PG8_BAR; PG8_SCHED;
            PG8_LDB(B1, 0, 1); PG8_STAGE(PG8_SB(0, 0), b2, voffB);
            PG8_BAR; PG8_WAIT_L(0); PG8_MMA(0, 1, At, B1); PG8_BAR;
            PG8_LDA(At, 0, 1); PG8_STAGE(PG8_SA(0, 0), a2, voffA);
            PG8_BAR; PG8_WAIT_L(0); PG8_MMA(1, 0, At, B0); PG8_BAR; PG8_SCHED;
            PG8_STAGE(PG8_SB(0, 1), b2 + hstep, voffB);
            PG8_WAIT_V(6); PG8_BAR; PG8_MMA(1, 1, At, B1); PG8_BAR;
            PG8_LDB(B0, 1, 0); PG8_SCHED; PG8_LDA(At, 1, 0); PG8_STAGE(PG8_SA(0, 1), a2 + hstep, voffA);
            PG8_WAIT_L(8); PG8_BAR; PG8_WAIT_L(0); PG8_MMA(0, 0, At, B0); PG8_BAR; PG8_SCHED;
            PG8_LDB(B1, 1, 1); PG8_STAGE(PG8_SB(1, 0), b3, voffB);
            PG8_BAR; PG8_WAIT_L(0); PG8_MMA(0, 1, At, B1); PG8_BAR;
            PG8_LDA(At, 1, 1); PG8_STAGE(PG8_SA(1, 0), a3, voffA);
            PG8_BAR; PG8_WAIT_L(0); PG8_MMA(1, 0, At, B0); PG8_BAR; PG8_SCHED;
            PG8_STAGE(PG8_SB(1, 1), b3 + hstep, voffB);
            PG8_WAIT_V(6); PG8_BAR; PG8_MMA(1, 1, At, B1); PG8_BAR;
            }
        }
        if constexpr (ALIGN_EPI) { if (wr == 0) PG8_BAR; }
        if constexpr (!Epi::AFTER_DRAIN) { E(acc, cur, wr, wc, fr, fq); S.done(cur); }
        if (!has_next) break;
#pragma unroll
        for (int a = 0; a < 2; ++a)
#pragma unroll
            for (int b = 0; b < 2; ++b)
#pragma unroll
                for (int m = 0; m < 4; ++m)
#pragma unroll
                    for (int n = 0; n < 2; ++n) acc[a][b][m][n] = (f32x4){0.f, 0.f, 0.f, 0.f};
        cur = nxt; cA = nA; cB = nB; ++ui;
        if constexpr (ALIGN_EPI) { if (wr == 1) PG8_BAR; }
    }
    PG8_WAIT_V(0);
    if constexpr (!ALIGN_EPI) { if (wr == 0) PG8_BAR; }
    PG8_BAR;
    if constexpr (Epi::AFTER_DRAIN) { E.fused(acc, cur, wr, wc, fr, fq, lds, wid, lane); S.done(cur); }
#undef PG8_SA
#undef PG8_SB
#undef PG8_STAGE
#undef PG8_LDA
#undef PG8_LDB
#undef PG8_MMA
#undef PG8_WAIT_V
#undef PG8_WAIT_L
#undef PG8_BAR
#undef PG8_SCHED
}
}
#define GAS __attribute__((address_space(1)))
#define LAS __attribute__((address_space(3)))
typedef unsigned short bf16;
typedef unsigned v4u __attribute__((ext_vector_type(4)));
typedef float f32x4 __attribute__((ext_vector_type(4)));
typedef short bf16x8 __attribute__((ext_vector_type(8)));
typedef GAS unsigned gu32;
typedef GAS unsigned long long gu64;
#define RLX_AGENT __ATOMIC_RELAXED, __HIP_MEMORY_SCOPE_AGENT
#define LDS_WAIT() asm volatile("s_waitcnt lgkmcnt(0)" ::: "memory")
#define VM_WAIT() asm volatile("s_waitcnt vmcnt(0)" ::: "memory")
__device__ __forceinline__ unsigned long long rt() { return __builtin_amdgcn_s_memrealtime(); }
__device__ __forceinline__ unsigned f2bf(float f) { unsigned u = __builtin_bit_cast(unsigned, f); return (u + 0x7fffu + ((u >> 16) & 1u)) >> 16; }
__device__ __forceinline__ unsigned pk2(float lo, float hi) { return f2bf(lo) | (f2bf(hi) << 16); }

#define XB_TMO      128
#define XB_XCNT(j)  (256  + 64 * (j))
#define XB_XSUB(j)  (1280 + 64 * (j))
#define XB_XGEN(j)  (2304 + 64 * (j))
#define XB_TOP      3328
#define XB_TOPGEN   3392
#define XCD_BAR_WORDS 3456
#define XB_SPIN_CAP (1u << 18)

__device__ __forceinline__ unsigned xb_ld(unsigned* p)              { return __hip_atomic_load(p, __ATOMIC_RELAXED, __HIP_MEMORY_SCOPE_AGENT); }
__device__ __forceinline__ unsigned xb_add(unsigned* p, unsigned v) { return __hip_atomic_fetch_add(p, v, __ATOMIC_RELAXED, __HIP_MEMORY_SCOPE_AGENT); }
__device__ __forceinline__ unsigned xb_xcc_id() { return (unsigned)__builtin_amdgcn_s_getreg((3 << 11) | 20) & 0xFu; }
#define XB_SPIN(cond, bar) do { unsigned _sp = 0; while (cond) { __builtin_amdgcn_s_sleep(1); \
    if ((++_sp & 255u) == 0u) { if (xb_ld(&(bar)[XB_TMO])) break; if (_sp > XB_SPIN_CAP) { atomicAdd(&(bar)[XB_TMO], 1u); break; } } } } while (0)

struct XcdBarrier {
    unsigned* bar; unsigned x;
    volatile LAS unsigned* st;
};

__device__ __forceinline__ XcdBarrier xcd_barrier_post(unsigned* bar, volatile LAS unsigned* st) {
    XcdBarrier b; b.bar = bar; b.x = xb_xcc_id(); b.st = st;
    if (threadIdx.x == 0) (void)xb_add(&bar[XB_XCNT(b.x)], 1u);
    return b;
}
__device__ __forceinline__ void xcd_barrier_complete(unsigned* bar, unsigned x, unsigned& nloc, unsigned& nx) {
    const unsigned G = gridDim.x * gridDim.y * gridDim.z;
    unsigned sum, cnt, mine, sp = 0u;
    for (;;) {
        sum = 0u; cnt = 0u; mine = 0u;
#pragma unroll
        for (unsigned j = 0; j < 16; ++j) { const unsigned c = xb_ld(&bar[XB_XCNT(j)]); sum += c; cnt += (c > 0u) ? 1u : 0u; mine = (j == x) ? c : mine; }
        if (sum == G) break;
        __builtin_amdgcn_s_sleep(1);
        if ((++sp & 255u) == 0u) { if (xb_ld(&bar[XB_TMO])) break; if (sp > XB_SPIN_CAP) { atomicAdd(&bar[XB_TMO], 1u); break; } }
    }
    nloc = mine > 0u ? mine : 1u; nx = cnt > 0u ? cnt : 1u;
}

__device__ __forceinline__ void xcd_barrier(const XcdBarrier& b) {
    asm volatile("s_waitcnt vmcnt(0)" ::: "memory");
    __syncthreads();
    if (threadIdx.x == 0) {
        unsigned* bar = b.bar;
        __builtin_amdgcn_s_waitcnt(0);
        unsigned nloc = b.st[0], nx = b.st[1];
        if (nloc == 0u) { xcd_barrier_complete(bar, b.x, nloc, nx); b.st[0] = nloc; b.st[1] = nx; }
        const unsigned old = xb_add(&bar[XB_XSUB(b.x)], 1u);
        const unsigned gen = old / nloc;
        if (old + 1u == (gen + 1u) * nloc) {
            __builtin_amdgcn_fence(__ATOMIC_RELEASE, "agent");
            asm volatile("s_waitcnt vmcnt(0)" ::: "memory");
            const unsigned og = xb_add(&bar[XB_TOP], 1u);
            const unsigned tg = og / nx;
            if (og + 1u == (tg + 1u) * nx) xb_add(&bar[XB_TOPGEN], 1u);
            else XB_SPIN(xb_ld(&bar[XB_TOPGEN]) == tg, bar);
            __builtin_amdgcn_fence(__ATOMIC_ACQUIRE, "agent");
            xb_add(&bar[XB_XGEN(b.x)], 1u);
            asm volatile("s_waitcnt vmcnt(0)" ::: "memory");
        } else {
            XB_SPIN(xb_ld(&bar[XB_XGEN(b.x)]) == gen, bar);
            __builtin_amdgcn_fence(__ATOMIC_ACQUIRE, "agent");
            asm volatile("s_waitcnt vmcnt(0)" ::: "memory");
        }
    }
    __syncthreads();
}

constexpr int NWAVES = 8;
constexpr int NB = 8, SEQ = 2048, D = 1024, M = NB * SEQ, FF = 2816, NFF2 = 2 * FF, NH = 8, CW = 31;
constexpr float EPS = 1e-6f;
constexpr float LOG2E = 1.4426950408889634f;
constexpr float QSCALE = 0.125f * LOG2E;
constexpr int N_PHASES = 22;

constexpr size_t MiB = 1u << 20;
constexpr size_t WS_CTL = 0, CTL_ZERO_BYTES = 64 * 1024;
constexpr size_t WS_SSQ = 1 * MiB;
constexpr size_t CONF_W_ELEMS = (size_t)2048 * 1024 + (size_t)1024 * 1024 + (size_t)5632 * 1024 + (size_t)1024 * 2816;
constexpr size_t ATT_W_ELEMS  = (size_t)3072 * 1024 + (size_t)1024 * 1024 + (size_t)5632 * 1024 + (size_t)1024 * 2816;
constexpr size_t CW_PW1 = 0, CW_PW2 = (size_t)2048 * 1024, CW_W13 = CW_PW2 + (size_t)1024 * 1024, CW_W2 = CW_W13 + (size_t)5632 * 1024;
constexpr size_t AW_QKV = 0, AW_WO = (size_t)3072 * 1024, AW_W13 = AW_WO + (size_t)1024 * 1024, AW_W2 = AW_W13 + (size_t)5632 * 1024;
constexpr size_t WS_WC = 2 * MiB;
constexpr size_t WS_WA = WS_WC + 2 * CONF_W_ELEMS * 2;
constexpr size_t WS_XB = WS_WA + 2 * ATT_W_ELEMS * 2;
constexpr size_t WS_V  = WS_XB + 32 * MiB;
constexpr size_t WS_R  = WS_V + 32 * MiB;
constexpr size_t WS_K  = WS_WC;
constexpr size_t WS_H = WS_R, WS_G = WS_R, WS_U = WS_R + 32 * MiB, WS_QO = WS_R, WS_O0 = WS_R + 32 * MiB;
constexpr size_t WS_END = WS_R + 96 * MiB;
static_assert(WS_WA == 47 * MiB && WS_XB == 96 * MiB && WS_R == 160 * MiB && WS_END == 256 * MiB, "d_ws map");
static_assert((size_t)M * FF * 2 <= 96 * MiB && WS_K + 32 * MiB <= WS_WA, "d_ws overlays");

constexpr int RING_OFF = 0, RING_BYTES = 131072;
constexpr int LDSCTL_OFF = RING_BYTES, MISC_OFF = LDSCTL_OFF + 320;
constexpr int LDS_BYTES = 147456;

typedef float f32x16 __attribute__((ext_vector_type(16)));
typedef short s16x4 __attribute__((ext_vector_type(4)));
typedef float f32x2 __attribute__((ext_vector_type(2)));
typedef unsigned u32x2 __attribute__((ext_vector_type(2)));
typedef unsigned u32x4 __attribute__((ext_vector_type(4)));

struct Args { const float* in[26]; float* out; unsigned char* ws; int ph_lo, ph_hi; float lam_init2, lam_init3; };
struct Frame {
    LAS unsigned char* lds; volatile LAS unsigned* MISC; gu32* ctl;
    int tid, lane, wave, vcu, G;
};
__device__ __forceinline__ float wave_sum(float v) {
#pragma unroll
    for (int o = 1; o < 64; o <<= 1) v += __shfl_xor(v, o);
    return v;
}
__device__ __forceinline__ float bf_lo(unsigned v) { return __uint_as_float(v << 16); }
__device__ __forceinline__ float bf_hi(unsigned v) { return __uint_as_float(v & 0xffff0000u); }

__device__ __forceinline__ void p0_transpose_item(const float* W, int ld, int K, int nblk, const float* gain, bf16* WT, int ilv, int row_off, LAS float* scr, int item, int lane) {
    const int kb = item / nblk, nb = item % nblk, k0 = 64 * kb, n0 = 32 * nb;
#pragma unroll 8
    for (int i = 0; i < 32; ++i) { const int kk = 2 * i + (lane >> 5); float v = W[(size_t)(k0 + kk) * ld + n0 + (lane & 31)]; if (gain) v *= gain[k0 + kk]; scr[kk * 33 + (lane & 31)] = v; }
    LDS_WAIT(); asm volatile("" ::: "memory");
    const int c = lane & 7;
    const int d0 = (ilv ? (((n0 >> 7) << 8) + (n0 & 127)) : n0) + row_off;
#pragma unroll
    for (int j = 0; j < 4; ++j) { const int n = (lane >> 3) + 8 * j; const LAS float* s = scr + (8 * c) * 33 + n;
        v4u o; o.x = pk2(s[0 * 33], s[1 * 33]); o.y = pk2(s[2 * 33], s[3 * 33]); o.z = pk2(s[4 * 33], s[5 * 33]); o.w = pk2(s[6 * 33], s[7 * 33]);
        *(GAS v4u*)(WT + (size_t)(d0 + n) * K + k0 + 8 * c) = o; }
    LDS_WAIT(); asm volatile("" ::: "memory");
}
__device__ __forceinline__ void p0_prologue(Frame& F, const Args& A) {
    LAS float* scr = (LAS float*)(F.lds + RING_OFF + F.wave * 16384);
    const int gw = F.vcu * NWAVES + F.wave, NGW = F.G * NWAVES;
    bf16* wsb = (bf16*)A.ws;
    for (int it0 = gw; it0 < 4 * 6272; it0 += NGW) {
        const int it = __builtin_amdgcn_readfirstlane(it0);
        const int L = it / 6272; int r = it % 6272; int slot;
        if (r < 2048) { slot = r >> 9; r &= 511; } else { r -= 2048; slot = 4 + r / 1408; r %= 1408; }
        const float* W; int ld, K, nblk, ilv = 0, row_off = 0; const float* gain = nullptr; bf16* dst;
        bf16* wl = (L < 2) ? wsb + WS_WC / 2 + (size_t)L * CONF_W_ELEMS : wsb + WS_WA / 2 + (size_t)(L - 2) * ATT_W_ELEMS;
        if (slot >= 4) {
            if (slot == 6) { W = A.in[24] + (size_t)L * FF * D; ld = D; K = FF; nblk = D / 32; dst = wl + (L < 2 ? CW_W2 : AW_W2); }
            else { W = (slot == 4 ? A.in[22] : A.in[23]) + (size_t)L * D * FF; ld = FF; K = D; nblk = FF / 32; ilv = 1; row_off = (slot == 4) ? 0 : 128; gain = A.in[21] + L * D; dst = wl + (L < 2 ? CW_W13 : AW_W13); }
        } else if (L < 2) {
            if (slot == 3) continue;
            if (slot == 2) { W = A.in[8] + (size_t)L * D * D; ld = D; K = D; nblk = D / 32; dst = wl + CW_PW2; }
            else { W = A.in[2] + (size_t)L * D * 2 * D + (slot == 1 ? D : 0); ld = 2 * D; K = D; nblk = D / 32; ilv = 1; row_off = (slot == 1) ? 128 : 0; gain = A.in[1] + L * D; dst = wl + CW_PW1; }
        } else {
            const int j = L - 2;
            if (slot == 0) { W = A.in[14] + (size_t)j * D * D; gain = A.in[13] + j * D; dst = wl + AW_QKV; }
            else if (slot == 1) { if (j) continue; W = A.in[11]; gain = A.in[10]; dst = wl + AW_QKV; row_off = 1024; }
            else if (slot == 2) { if (j) continue; W = A.in[12]; gain = A.in[10]; dst = wl + AW_QKV; row_off = 2048; }
            else { W = A.in[20] + (size_t)j * D * D; dst = wl + AW_WO; }
            ld = D; K = D; nblk = D / 32;
        }
        p0_transpose_item(W, ld, K, nblk, gain, dst, ilv, row_off, scr, r, F.lane);
    }
    const float* x = A.in[0]; bf16* XB = (bf16*)(A.ws + WS_XB); float* ssq = (float*)(A.ws + WS_SSQ);
    for (int m = gw; m < M; m += NGW) {
        const GAS f32x4* xr = (const GAS f32x4*)(x + (size_t)m * D) + F.lane; f32x4 v[4]; float s = 0.f;
#pragma unroll
        for (int j = 0; j < 4; ++j) { v[j] = xr[64 * j]; s += (v[j].x * v[j].x + v[j].y * v[j].y) + (v[j].z * v[j].z + v[j].w * v[j].w); }
        s = wave_sum(s);
        GAS unsigned long long* o8 = (GAS unsigned long long*)(XB + (size_t)m * D) + F.lane;
#pragma unroll
        for (int j = 0; j < 4; ++j) o8[64 * j] = (unsigned long long)pk2(v[j].x, v[j].y) | ((unsigned long long)pk2(v[j].z, v[j].w) << 32);
        if (F.lane == 0) *(GAS f32x4*)(ssq + (size_t)m * 4) = (f32x4){s, 0.f, 0.f, 0.f};
    }
}
__device__ __forceinline__ void final_phase(Frame& F, float* X, const float* g) {
    const int gw = F.vcu * NWAVES + F.wave, NGW = F.G * NWAVES;
    f32x4 gv[4];
#pragma unroll
    for (int j = 0; j < 4; ++j) gv[j] = *((const GAS f32x4*)g + F.lane + 64 * j);
    for (int m = gw; m < M; m += NGW) {
        GAS f32x4* xr = (GAS f32x4*)(X + (size_t)m * D) + F.lane; f32x4 v[4]; float s = 0.f;
#pragma unroll
        for (int j = 0; j < 4; ++j) { v[j] = xr[64 * j]; s += (v[j].x * v[j].x + v[j].y * v[j].y) + (v[j].z * v[j].z + v[j].w * v[j].w); }
        const float rs = 1.0f / sqrtf(wave_sum(s) * (1.0f / D) + EPS);
#pragma unroll
        for (int j = 0; j < 4; ++j) xr[64 * j] = v[j] * rs * gv[j];
    }
}
__device__ __forceinline__ void conv_phase(Frame& F, const bf16* G, bf16* U, const float* dww, const float* dwb, const float* lng, const float* lnb) {
    LAS float* red = (LAS float*)(F.lds + RING_OFF);
    const int c0 = 2 * F.tid;
    f32x2 w[CW];
#pragma unroll
    for (int j = 0; j < CW; ++j) w[j] = *(const GAS f32x2*)(dww + j * D + c0);
    const f32x2 bb = *(const GAS f32x2*)(dwb + c0), gg = *(const GAS f32x2*)(lng + c0), be = *(const GAS f32x2*)(lnb + c0);
    for (int unit = F.vcu; unit < M / 32; unit += F.G) {
        const int row0 = unit * 32; const bool head = ((row0 & (SEQ - 1)) == 0);
        f32x2 acc[32];
#pragma unroll
        for (int p = 0; p < 32; ++p) acc[p] = (f32x2){0.f, 0.f};
#pragma unroll
        for (int i = 0; i < 62; ++i) {
            int rr = row0 - 30 + i; float msk = 1.0f;
            if (i < 30) { rr = head ? row0 : rr; msk = head ? 0.0f : 1.0f; }
            const unsigned v = *(const GAS unsigned*)(G + (size_t)rr * D + c0);
            const f32x2 g = (f32x2){bf_lo(v) * msk, bf_hi(v) * msk};
#pragma unroll
            for (int p = (i > 30 ? i - 30 : 0); p <= (i < 31 ? i : 31); ++p) acc[p] += w[i - p] * g;
        }
        float v[64];
#pragma unroll
        for (int p = 0; p < 32; ++p) { acc[p] += bb; v[p] = acc[p].x + acc[p].y; v[32 + p] = acc[p].x * acc[p].x + acc[p].y * acc[p].y; }
#pragma unroll
        for (int o = 32, n = 32; o >= 1; o >>= 1, n >>= 1) {
            const bool up = (F.lane & o) != 0;
#pragma unroll
            for (int i = 0; i < n; ++i) { const float send = up ? v[i] : v[i + n]; const float keep = up ? v[i + n] : v[i]; v[i] = keep + __shfl_xor(send, o); }
        }
        __syncthreads();
        red[F.wave * 64 + F.lane] = v[0];
        __syncthreads();
        if (F.tid < 64) { float t = 0.f;
#pragma unroll
            for (int wv = 0; wv < 8; ++wv) t += red[wv * 64 + F.tid];
            red[512 + F.tid] = t; }
        __syncthreads();
#pragma unroll
        for (int p = 0; p < 32; ++p) {
            const float mean = red[512 + p] * (1.0f / D), var = red[512 + 32 + p] * (1.0f / D) - mean * mean, rs = 1.0f / sqrtf(fmaxf(var, 0.f) + EPS);
            const f32x2 y = (acc[p] - mean) * rs * gg + be;
            const float s0 = y.x * pg8::sigmoidf_(y.x), s1 = y.y * pg8::sigmoidf_(y.y);
            *(GAS unsigned*)(U + (size_t)(row0 + p) * D + c0) = pk2(s0, s1);
        }
    }
}
__device__ __forceinline__ int crow(int r, int hi) { return (r & 3) + 8 * (r >> 2) + 4 * hi; }
constexpr int ATT_BUF = 24576;
__device__ __forceinline__ void attn_unit(Frame& F, int b, int h, int qb, const bf16* Qb, const bf16* Kb, const bf16* Vb, bf16* Ob, float* O0, float lam, float lam_init, const float* subg) {
    const int lane = F.lane, r32 = lane & 31, hi = lane >> 5, wid = F.wave;
    LAS unsigned char* lds = F.lds + RING_OFF;
    LAS float* wsf = (LAS float*)(lds + 2 * ATT_BUF) + wid * 64;
    const size_t rowbase = (size_t)b * SEQ; const int q0 = qb * 256, NT = 4 * (qb + 1);
    const int tq = q0 + 32 * wid + r32;
    const float sl2 = LOG2E * __builtin_amdgcn_exp2f(-(float)(h + 1));
    const int unit_lin = (b * NH + h) * 8 + qb;
    float* park = O0 + ((size_t)(unit_lin * 8 + wid) * 64 + lane) * 64;
    const int kdst = wid * 1024 + lane * 16;
    const LAS unsigned char* kp0 = lds + hi * 1024 + r32 * 16;
    const LAS unsigned char* vp0 = lds + 8192 + ((lane >> 4) & 1) * 32 + (lane & 3) * 8 + (4 * hi + ((lane & 15) >> 2)) * 64;
#pragma unroll 1
    for (int c = 0; c < 2; ++c) {
        const bf16* Qw = Qb + (rowbase + q0 + wid * 32) * D + (2 * h + c) * 64;
        bf16x8 qr[4];
#pragma unroll
        for (int d0 = 0; d0 < 4; ++d0) qr[d0] = *(const GAS bf16x8*)(Qw + (size_t)r32 * D + d0 * 16 + hi * 8);
        const bf16* ksrc = Kb + (rowbase + lane) * D + (2 * h + c) * 64 + wid * 8;
        const bf16* vsrc0 = Vb + (rowbase + 16 * (wid & 3) + (lane >> 2)) * D + h * 128 + (wid >> 2) * 32 + (lane & 3) * 8;
        const bf16* vsrc1 = vsrc0 + 64;
        f32x16 o[4];
#pragma unroll
        for (int d0 = 0; d0 < 4; ++d0) o[d0] = (f32x16){};
        float m_run = -1e30f, l_run = 0.f;
        { const v4u k0 = *(const GAS v4u*)ksrc, v0 = *(const GAS v4u*)vsrc0, v1 = *(const GAS v4u*)vsrc1;
          *(LAS v4u*)(lds + kdst) = k0; *(LAS v4u*)(lds + 8192 + kdst) = v0; *(LAS v4u*)(lds + 8192 + 8192 + kdst) = v1; }
        __syncthreads();
#pragma unroll 1
        for (int t = 0; t < NT; ++t) {
            const int bo = (t & 1) * ATT_BUF, bn = ((t + 1) & 1) * ATT_BUF; const bool more = (t + 1 < NT);
            v4u kn = {}, vn0 = {}, vn1 = {};
            if (more) { const size_t go = (size_t)(t + 1) * 64 * D; kn = *(const GAS v4u*)(ksrc + go); vn0 = *(const GAS v4u*)(vsrc0 + go); vn1 = *(const GAS v4u*)(vsrc1 + go); }
            const float cb = sl2 * (float)(64 * t + 4 * hi - tq);
            f32x16 p0, p1;
#pragma unroll
            for (int r = 0; r < 16; ++r) { p0[r] = cb; p1[r] = cb + 32.0f * sl2; }
#pragma unroll
            for (int d0 = 0; d0 < 4; ++d0) {
                const bf16x8 k0 = *(const LAS bf16x8*)(kp0 + bo + d0 * 2048), k1 = *(const LAS bf16x8*)(kp0 + bo + d0 * 2048 + 512);
                p0 = __builtin_amdgcn_mfma_f32_32x32x16_bf16(k0, qr[d0], p0, 0, 0, 0); p1 = __builtin_amdgcn_mfma_f32_32x32x16_bf16(k1, qr[d0], p1, 0, 0, 0); }
#pragma unroll
            for (int r = 0; r < 16; ++r) { const float kr = (float)((r & 3) + 8 * (r >> 2)); p0[r] = __builtin_fmaf(sl2, kr, p0[r]); p1[r] = __builtin_fmaf(sl2, kr, p1[r]); }
            if (t >= NT - 4) { const int kb = 64 * t + 4 * hi;
#pragma unroll
                for (int r = 0; r < 16; ++r) { const int kv = kb + (r & 3) + 8 * (r >> 2); if (kv > tq) p0[r] = -INFINITY; if (kv + 32 > tq) p1[r] = -INFINITY; } }
            float mt = fmaxf(p0[0], p1[0]);
#pragma unroll
            for (int r = 1; r < 16; ++r) mt = fmaxf(mt, fmaxf(p0[r], p1[r]));
            mt = fmaxf(mt, __shfl_xor(mt, 32));
            const float m_new = fmaxf(m_run, mt), alpha = __builtin_amdgcn_exp2f(m_run - m_new); m_run = m_new;
            float ls = 0.f;
#pragma unroll
            for (int r = 0; r < 16; ++r) { p0[r] = __builtin_amdgcn_exp2f(p0[r] - m_new); p1[r] = __builtin_amdgcn_exp2f(p1[r] - m_new); ls += p0[r] + p1[r]; }
            l_run = l_run * alpha + ls;
            if (hi == 0) wsf[r32] = alpha;
            u32x4 pw[4];
#pragma unroll
            for (int k = 0; k < 4; ++k) { pw[0][k] = pg8::cvt_pk_bf16(p0[2 * k], p0[2 * k + 1]); pw[1][k] = pg8::cvt_pk_bf16(p0[8 + 2 * k], p0[8 + 2 * k + 1]);
                                           pw[2][k] = pg8::cvt_pk_bf16(p1[2 * k], p1[2 * k + 1]); pw[3][k] = pg8::cvt_pk_bf16(p1[8 + 2 * k], p1[8 + 2 * k + 1]); }
            float al[16];
#pragma unroll
            for (int r = 0; r < 16; ++r) al[r] = wsf[crow(r, hi)];
#pragma unroll
            for (int d0 = 0; d0 < 4; ++d0) {
#pragma unroll
                for (int r = 0; r < 16; ++r) o[d0][r] *= al[r];
#pragma unroll
                for (int ks = 0; ks < 4; ++ks) {
                    const s16x4 lo = __builtin_bit_cast(s16x4, __builtin_amdgcn_ds_read_tr16_b64_v4i16((LAS s16x4*)(vp0 + bo + d0 * 4096 + ks * 1024)));
                    const s16x4 hh = __builtin_bit_cast(s16x4, __builtin_amdgcn_ds_read_tr16_b64_v4i16((LAS s16x4*)(vp0 + bo + d0 * 4096 + ks * 1024 + 512)));
                    const bf16x8 vf = (bf16x8){lo[0], lo[1], lo[2], lo[3], hh[0], hh[1], hh[2], hh[3]};
                    o[d0] = __builtin_amdgcn_mfma_f32_32x32x16_bf16(__builtin_bit_cast(bf16x8, pw[ks]), vf, o[d0], 0, 0, 0); } }
            if (more) { *(LAS v4u*)(lds + bn + kdst) = kn; *(LAS v4u*)(lds + bn + 8192 + kdst) = vn0; *(LAS v4u*)(lds + bn + 16384 + kdst) = vn1; }
            __syncthreads();
        }
        l_run += __shfl_xor(l_run, 32);
        if (hi == 0) wsf[32 + r32] = l_run;
        float rl[16];
#pragma unroll
        for (int r = 0; r < 16; ++r) rl[r] = 1.0f / wsf[32 + crow(r, hi)];
        if (c == 0) {
#pragma unroll
            for (int d0 = 0; d0 < 4; ++d0)
#pragma unroll
                for (int q = 0; q < 4; ++q) *(GAS f32x4*)(park + d0 * 16 + q * 4) = (f32x4){o[d0][4 * q] * rl[4 * q], o[d0][4 * q + 1] * rl[4 * q + 1], o[d0][4 * q + 2] * rl[4 * q + 2], o[d0][4 * q + 3] * rl[4 * q + 3]};
        } else {
            asm volatile("s_waitcnt vmcnt(0)" ::: "memory");
            float ss[16];
#pragma unroll
            for (int r = 0; r < 16; ++r) ss[r] = 0.f;
#pragma unroll
            for (int d0 = 0; d0 < 4; ++d0)
#pragma unroll
                for (int q = 0; q < 4; ++q) { const f32x4 pk = *(const GAS f32x4*)(park + d0 * 16 + q * 4);
#pragma unroll
                    for (int i = 0; i < 4; ++i) { const int r = 4 * q + i; const float v = pk[i] - lam * (o[d0][r] * rl[r]); o[d0][r] = v; ss[r] += v * v; } }
#pragma unroll
            for (int r = 0; r < 16; ++r) {
#pragma unroll
                for (int o2 = 1; o2 < 32; o2 <<= 1) ss[r] += __shfl_xor(ss[r], o2);
                ss[r] = (1.0f - lam_init) / sqrtf(ss[r] * (1.0f / 128.0f) + EPS); }
            float gsub[4];
#pragma unroll
            for (int d0 = 0; d0 < 4; ++d0) gsub[d0] = subg[32 * d0 + r32];
            bf16* Ow = Ob + (rowbase + q0 + wid * 32 + 4 * hi + 2) * D + h * 128 + r32;
#pragma unroll
            for (int g = 0; g < 4; ++g) { asm volatile("" : "+v"(Ow));
#pragma unroll
                for (int i = 0; i < 4; ++i)
#pragma unroll
                    for (int d0 = 0; d0 < 4; ++d0) Ow[(i - 2) * D + 32 * d0] = (bf16)f2bf(o[d0][4 * g + i] * ss[4 * g + i] * gsub[d0]);
                Ow += 8 * D; }
        }
        __syncthreads();
    }
}
__device__ __forceinline__ void attn_phase(Frame& F, const Args& A, int j, float lam_init) {
    const bf16* Qb = (const bf16*)(A.ws + WS_QO); const bf16* Kb = (const bf16*)(A.ws + WS_K); const bf16* Vb = (const bf16*)(A.ws + WS_V);
    bf16* Ob = (bf16*)(A.ws + WS_QO); float* O0 = (float*)(A.ws + WS_O0);
    const float a = wave_sum(A.in[15][j * 64 + F.lane] * A.in[16][j * 64 + F.lane]), b2 = wave_sum(A.in[17][j * 64 + F.lane] * A.in[18][j * 64 + F.lane]);
    const float lam = expf(a) - expf(b2) + lam_init;
    const float* subg = A.in[19] + j * 128;
    for (int w = 2 * F.vcu; w < NB * NH * 8; w += 2 * F.G) {
#pragma unroll 1
        for (int e = 0; e < 2; ++e) { const int ww = w + e, bh = ww >> 3, k = ww & 7, qb = (k & 1) ? 7 - (k >> 1) : (k >> 1);
            attn_unit(F, bh >> 3, bh & 7, qb, Qb, Kb, Vb, Ob, O0, lam, lam_init, subg); }
    }
}

__global__ void __launch_bounds__(NWAVES * 64, 2) yoco_fwd(Args args) {
    extern __shared__ __attribute__((aligned(16))) unsigned char lds_raw[];
    Frame F;
    F.lds = (LAS unsigned char*)lds_raw;
    F.MISC = (volatile LAS unsigned*)(F.lds + MISC_OFF);
    F.tid = threadIdx.x; F.lane = F.tid & 63; F.wave = __builtin_amdgcn_readfirstlane(F.tid >> 6);
    F.G = gridDim.x; { const int bx = blockIdx.x; F.vcu = (F.G % 8 == 0) ? (bx % 8) * (F.G / 8) + bx / 8 : bx; }
    unsigned char* ws = args.ws;
    F.ctl = (gu32*)(ws + WS_CTL);
    for (int u = F.tid; u < (LDS_BYTES - LDSCTL_OFF) / 4; u += NWAVES * 64) ((LAS unsigned*)(F.lds + LDSCTL_OFF))[u] = 0u;
    __syncthreads();
    const int lo = args.ph_lo, hi = args.ph_hi;
    XcdBarrier bar; bar.bar = (unsigned*)F.ctl; bar.x = 0; bar.st = nullptr;
    if (hi - lo > 1) bar = xcd_barrier_post((unsigned*)F.ctl, F.MISC + 8);

    bf16* wsb = (bf16*)ws;
    bf16* XB = (bf16*)(ws + WS_XB); float* SSQ = (float*)(ws + WS_SSQ); float* X = args.out;
#pragma unroll 1
    for (int ph = lo; ph < hi; ++ph) {
        { int t_ = threadIdx.x; asm volatile("" : "+v"(t_)); F.tid = t_; F.lane = t_ & 63; F.wave = __builtin_amdgcn_readfirstlane(t_ >> 6); }
        if (ph == 0) p0_prologue(F, args);
        else if (ph == N_PHASES - 1) final_phase(F, X, args.in[25]);
        else {
            const int L = (ph - 1) / 5, k = (ph - 1) % 5;
            bf16* wl = (L < 2) ? wsb + WS_WC / 2 + (size_t)L * CONF_W_ELEMS : wsb + WS_WA / 2 + (size_t)(L - 2) * ATT_W_ELEMS;
            if (k == 0 && L < 2) {
                pg8::Gemm g{XB, wl + CW_PW1, M, 2 * D, D}; pg8::StaticOrder S; S.init(M, 2 * D, F.G, (int)blockIdx.x);
                pg8::EpiGate<0> E{(bf16*)(ws + WS_G), D, SSQ, args.in[3] + L * 2 * D};
                pg8::gemm_phase<pg8::EpiGate<0>, pg8::StaticOrder, true, true>(F.lds + RING_OFF, g, S, E);
            } else if (k == 0) {
                const int N = (L == 2) ? 3 * D : D;
                pg8::Gemm g{XB, wl + AW_QKV, M, N, D}; pg8::StaticOrder S; S.init(M, N, F.G, (int)blockIdx.x);
                typedef pg8::EpiQKV<WS_QO, WS_K, WS_V> EQ; EQ E{ws, SSQ, QSCALE};
                pg8::gemm_phase<EQ, pg8::StaticOrder, true, true>(F.lds + RING_OFF, g, S, E);
            } else if (k == 1 && L < 2) {
                conv_phase(F, (const bf16*)(ws + WS_G), (bf16*)(ws + WS_U), args.in[4] + L * CW * D, args.in[5] + L * D, args.in[6] + L * D, args.in[7] + L * D);
            } else if (k == 1) {
                attn_phase(F, args, L - 2, L == 2 ? args.lam_init2 : args.lam_init3);
            } else if (k == 3) {
                pg8::Gemm g{XB, wl + (L < 2 ? CW_W13 : AW_W13), M, NFF2, D}; pg8::StaticOrder S; S.init(M, NFF2, F.G, (int)blockIdx.x);
                pg8::EpiGate<1> E{(bf16*)(ws + WS_H), FF, SSQ, nullptr};
                pg8::gemm_phase<pg8::EpiGate<1>, pg8::StaticOrder, true, true>(F.lds + RING_OFF, g, S, E);
            } else {
                const bf16* Aop; const bf16* Bop; int K; const float* bias = nullptr; const float* base = X;
                if (k == 4) { Aop = (const bf16*)(ws + WS_H); Bop = wl + (L < 2 ? CW_W2 : AW_W2); K = FF; }
                else if (L < 2) { Aop = (const bf16*)(ws + WS_U); Bop = wl + CW_PW2; K = D; bias = args.in[9] + L * D; if (L == 0) base = args.in[0]; }
                else { Aop = (const bf16*)(ws + WS_QO); Bop = wl + AW_WO; K = D; }
                pg8::Gemm g{Aop, Bop, M, D, K}; pg8::StaticOrder S; S.init(M, D, F.G, (int)blockIdx.x);
                pg8::EpiRes E{base, X, XB, SSQ, bias};
                if (F.G == 256) pg8::gemm_phase<pg8::EpiRes, pg8::StaticOrder, false, true>(F.lds + RING_OFF, g, S, E);
            }
        }
        if (ph + 1 < hi) xcd_barrier(bar);
    }
}

#ifndef MK_ONE_LAUNCH
#define MK_ONE_LAUNCH 0
#endif
extern "C" void kernel_launch(void* const* d_in, const int* in_sizes, int n_in, void* d_out, int out_size, void* d_ws, size_t ws_size, hipStream_t stream) {
    static int grid = 0;
    if (grid == 0) {
        if (n_in != 26 || in_sizes[0] != M * D || out_size != M * D || ws_size < WS_END) { fprintf(stderr, "kernel_launch: unexpected shapes (n_in %d, in0 %d, out %d, ws %zu); nothing launched\n", n_in, n_in > 0 ? in_sizes[0] : -1, out_size, ws_size); grid = -1; return; }
        int dev = 0, cus = 0, per_cu = 0;
        if (hipGetDevice(&dev) != hipSuccess || hipDeviceGetAttribute(&cus, hipDeviceAttributeMultiprocessorCount, dev) != hipSuccess) { grid = -1; return; }
        if (hipFuncSetAttribute((const void*)yoco_fwd, hipFuncAttributeMaxDynamicSharedMemorySize, LDS_BYTES) != hipSuccess) { fprintf(stderr, "kernel_launch: hipFuncSetAttribute failed\n"); grid = -1; return; }
        if (hipOccupancyMaxActiveBlocksPerMultiprocessor(&per_cu, (const void*)yoco_fwd, NWAVES * 64, LDS_BYTES) != hipSuccess || per_cu < 1) { fprintf(stderr, "kernel_launch: occupancy query says %d blocks per CU\n", per_cu); }
        (void)hipGetLastError();
        grid = cus;
        if (grid != 256) fprintf(stderr, "kernel_launch: %d CUs; the residual GEMM phases need exactly 256 workgroups\n", grid);
    }
    if (grid < 0) return;
    if (hipMemsetAsync((char*)d_ws + WS_CTL, 0, CTL_ZERO_BYTES, stream) != hipSuccess) return;
    Args a{};
    for (int i = 0; i < 26; ++i) a.in[i] = (const float*)d_in[i];
    a.out = (float*)d_out; a.ws = (unsigned char*)d_ws;
    a.lam_init2 = (float)(0.8 - 0.6 * exp(-0.3 * 2.0)); a.lam_init3 = (float)(0.8 - 0.6 * exp(-0.3 * 3.0));
#if MK_ONE_LAUNCH
    a.ph_lo = 0; a.ph_hi = N_PHASES;
    hipLaunchKernelGGL(yoco_fwd, dim3(grid), dim3(NWAVES * 64), LDS_BYTES, stream, a);
#else
    for (int p = 0; p < N_PHASES; ++p) { a.ph_lo = p; a.ph_hi = p + 1; hipLaunchKernelGGL(yoco_fwd, dim3(grid), dim3(NWAVES * 64), LDS_BYTES, stream, a); }
#endif
}
```

```cpp
#define MK_ONE_LAUNCH 1
#define PROBE_REP 0
#include <hip/hip_runtime.h>
#include <cstdio>
#include <cstdint>
#include <cmath>
namespace pg8 {
#define PG8_LAS __attribute__((address_space(3)))
typedef unsigned short bf16_t;
typedef short bf16x8 __attribute__((ext_vector_type(8)));
typedef float f32x4 __attribute__((ext_vector_type(4)));
typedef unsigned u32x4 __attribute__((ext_vector_type(4)));
constexpr int BM = 256, BK = 64, HALF = 128, HTB = HALF * BK * 2  , STAGE_BYTES = 8 * HTB, NXCD = 8, WGM = 8;

__host__ __device__ __forceinline__ int lds_byte(int r, int c) { const int st = (r >> 4) * 2 + (c >> 5), rr = r & 15, cc = c & 31, ob = rr * 64 + cc * 2; return st * 1024 + (ob ^ (((ob >> 9) & 1) << 5)); }
__host__ __device__ __forceinline__ void stage_rc(int b, int& R, int& C) { const int st = b / 1024, sb = b % 1024, swz = sb ^ (((sb >> 9) & 1) << 5); R = (st >> 1) * 16 + swz / 64; C = (st & 1) * 32 + (swz % 64) / 2; }
__host__ __device__ __forceinline__ int perm32(int rho) { const int n = rho >> 4, i = rho & 15; return 8 * (i >> 2) + 4 * n + (i & 3); }

struct Unit { int pm, pn; };
struct Gemm { const bf16_t* A; const bf16_t* Bt; int M, N, K; };

struct StaticOrder {
    int nM, nN, nwg, G, c;
    __host__ __device__ void init(int M, int N, int G_, int c_) { nM = M / BM; nN = N / BM; nwg = nM * nN; G = G_; c = c_; }
    __host__ __device__ bool next(int i, Unit& u) const {
        const long L = (long)i * G + c; if (L >= nwg) return false;
        int wgid = (int)L; { const int q = nwg / NXCD, r = nwg % NXCD, xcd = wgid % NXCD, off = wgid / NXCD; wgid = (xcd < r ? xcd * (q + 1) : r * (q + 1) + (xcd - r) * q) + off; }
        const int nig = WGM * nN, gid = wgid / nig, fm = gid * WGM, gsz = (nM - fm) < WGM ? (nM - fm) : WGM;
        u.pm = fm + ((wgid % nig) % gsz); u.pn = (wgid % nig) / gsz; return true;
    }
    __device__ __forceinline__ void a_ready(const Unit&) const {}
    __device__ __forceinline__ void done(const Unit&) const {}
};

__device__ __forceinline__ unsigned cvt_pk_bf16(float lo, float hi) { unsigned r; asm volatile("v_cvt_pk_bf16_f32 %0, %1, %2" : "=v"(r) : "v"(lo), "v"(hi)); return r; }
typedef unsigned u32x2 __attribute__((ext_vector_type(2)));
constexpr float NORM_EPS = 1e-6f;
__device__ __forceinline__ float row_rstd(const float* ssq, int row) { const f32x4 s = *(const f32x4*)(ssq + (size_t)row * 4); return __builtin_amdgcn_rsqf(((s[0] + s[1]) + (s[2] + s[3])) * (1.0f / 1024.0f) + NORM_EPS); }
__device__ __forceinline__ float sigmoidf_(float x) { return __builtin_amdgcn_rcpf(1.0f + __builtin_amdgcn_exp2f(-1.4426950408889634f * x)); }

template <int MODE> struct EpiGate {
    static constexpr bool PERM = true, AFTER_DRAIN = false;
    bf16_t* O; int ldc; const float* ssq; const float* bias;
    __device__ __forceinline__ void operator()(const f32x4 (&acc)[2][2][4][2], const Unit& u, int wr, int wc, int fr, int fq) const {
        const int row0 = u.pm * BM + wr * 64 + fr, ch0 = u.pn * HALF + wc * 32 + 8 * fq;
        f32x4 ba[2], bg[2];
#pragma unroll
        for (int n = 0; n < 2; ++n) {
            if (MODE == 0) { ba[n] = *(const f32x4*)(bias + ch0 + 4 * n); bg[n] = *(const f32x4*)(bias + 1024 + ch0 + 4 * n); }
            else { ba[n] = (f32x4){0.f, 0.f, 0.f, 0.f}; bg[n] = (f32x4){0.f, 0.f, 0.f, 0.f}; } }
        float rsv[2][4];
#pragma unroll
        for (int ai = 0; ai < 2; ++ai)
#pragma unroll
            for (int m = 0; m < 4; ++m) rsv[ai][m] = row_rstd(ssq, row0 + ai * HALF + m * 16);
        asm volatile("" ::: "memory");
#pragma unroll
        for (int ai = 0; ai < 2; ++ai)
#pragma unroll
            for (int m = 0; m < 4; ++m) { const int row = row0 + ai * HALF + m * 16; const float rs = rsv[ai][m];
                u32x4 w;
#pragma unroll
                for (int n = 0; n < 2; ++n) { const f32x4 a = acc[ai][0][m][n] * rs + ba[n], g = acc[ai][1][m][n] * rs + bg[n]; f32x4 y;
#pragma unroll
                    for (int i = 0; i < 4; ++i) y[i] = (MODE == 0) ? a[i] * sigmoidf_(g[i]) : (a[i] * sigmoidf_(a[i])) * g[i];
                    w[2 * n] = cvt_pk_bf16(y[0], y[1]); w[2 * n + 1] = cvt_pk_bf16(y[2], y[3]); }
                *(u32x4*)(O + (size_t)row * ldc + ch0) = w; asm volatile("" ::: "memory"); }
    }
};
template <size_t OFFQ, size_t OFFK, size_t OFFV> struct EpiQKV {
    static constexpr bool PERM = true, AFTER_DRAIN = false;
    unsigned char* ws; const float* ssq; float qscale;
    __device__ __forceinline__ void operator()(const f32x4 (&acc)[2][2][4][2], const Unit& u, int wr, int wc, int fr, int fq) const {
        const int row0 = u.pm * BM + wr * 64 + fr; int colt = u.pn * BM; const int t = colt >> 10; colt &= 1023;
        const size_t boff = (t == 0 ? OFFQ : 0) + (t == 1 ? OFFK : 0) + (t == 2 ? OFFV : 0);
        bf16_t* base = (bf16_t*)(ws + boff); const float sc = (t == 0) ? qscale : 1.0f;
        const int col0 = colt + wc * 32 + 8 * fq;
        float rsv[2][4];
#pragma unroll
        for (int ai = 0; ai < 2; ++ai)
#pragma unroll
            for (int m = 0; m < 4; ++m) rsv[ai][m] = row_rstd(ssq, row0 + ai * HALF + m * 16) * sc;
        asm volatile("" ::: "memory");
#pragma unroll
        for (int ai = 0; ai < 2; ++ai)
#pragma unroll
            for (int m = 0; m < 4; ++m) { const int row = row0 + ai * HALF + m * 16; const float rs = rsv[ai][m]; bf16_t* rowp = base + (size_t)row * 1024 + col0;
#pragma unroll
                for (int bj = 0; bj < 2; ++bj) { const f32x4 v0 = acc[ai][bj][m][0] * rs, v1 = acc[ai][bj][m][1] * rs; u32x4 w;
                    w.x = cvt_pk_bf16(v0[0], v0[1]); w.y = cvt_pk_bf16(v0[2], v0[3]); w.z = cvt_pk_bf16(v1[0], v1[1]); w.w = cvt_pk_bf16(v1[2], v1[3]);
                    *(u32x4*)(rowp + bj * HALF) = w; } asm volatile("" ::: "memory"); }
    }
};
struct EpiRes {
    static constexpr bool PERM = false, AFTER_DRAIN = true;
    const float* base; float* out; bf16_t* xb; float* ssq; const float* bias;
    __device__ __forceinline__ void fused(f32x4 (&acc)[2][2][4][2], const Unit& u, int wr, int wc, int fr, int fq, PG8_LAS unsigned char* lds, int wid, int lane) const {
        const int col0 = u.pn * BM + wc * 32 + 4 * fq;
        PG8_LAS float* P = (PG8_LAS float*)lds;
        f32x4 bv[2][2];
#pragma unroll
        for (int bj = 0; bj < 2; ++bj)
#pragma unroll
            for (int n = 0; n < 2; ++n) bv[bj][n] = bias ? *(const f32x4*)(bias + col0 + bj * HALF + n * 16) : (f32x4){0.f, 0.f, 0.f, 0.f};
#pragma unroll
        for (int ai = 0; ai < 2; ++ai)
#pragma unroll
            for (int m = 0; m < 4; ++m) { const int r = ai * HALF + wr * 64 + m * 16 + fr; const size_t off = (size_t)(u.pm * BM + r) * 1024 + col0; float ss = 0.f;
#pragma unroll
                for (int bj = 0; bj < 2; ++bj)
#pragma unroll
                    for (int n = 0; n < 2; ++n) { const size_t c = off + bj * HALF + n * 16; const f32x4 bs = *(const f32x4*)(base + c); const f32x4 o = bs + acc[ai][bj][m][n] + bv[bj][n];
                        *(f32x4*)(out + c) = o; u32x2 w; w.x = cvt_pk_bf16(o[0], o[1]); w.y = cvt_pk_bf16(o[2], o[3]); *(u32x2*)(xb + c) = w;
                        ss += (o[0] * o[0] + o[1] * o[1]) + (o[2] * o[2] + o[3] * o[3]); }
                ss += __shfl_xor(ss, 16); ss += __shfl_xor(ss, 32);
                if (fq == 0) P[r * 4 + wc] = ss;
                if (m & 1) asm volatile("" ::: "memory"); }
        asm volatile("s_waitcnt lgkmcnt(0)" ::: "memory"); __builtin_amdgcn_s_barrier(); asm volatile("" ::: "memory");
        const int tid = wid * 64 + lane;
        if (tid < 256) { const PG8_LAS f32x4* P4 = (const PG8_LAS f32x4*)lds; const f32x4 p = P4[tid]; ssq[(size_t)(u.pm * BM + tid) * 4 + u.pn] = (p[0] + p[1]) + (p[2] + p[3]); }
    }
};

template <class Epi, class Sched, bool ALIGN_EPI = false, bool SP2 = false>
__device__ __forceinline__ void gemm_phase(PG8_LAS unsigned char* lds, const Gemm g, const Sched& S, const Epi& E) {
    int tid_ = threadIdx.x; asm volatile("" : "+v"(tid_));
    const int tid = tid_, wid = __builtin_amdgcn_readfirstlane(tid >> 6), lane = tid & 63, wr = wid >> 2, wc = wid & 3, fr = lane & 15, fq = lane >> 4;
    const int K = g.K, nt = K / BK;
    unsigned voffA[2], voffB[2];
#pragma unroll
    for (int i = 0; i < 2; ++i) { int R, C; stage_rc(tid * 16 + i * 8192, R, C); const int Rb = Epi::PERM ? ((R & ~31) + perm32(R & 31)) : R;
        voffA[i] = (unsigned)(R * K + C) * 2u; voffB[i] = (unsigned)(Rb * K + C) * 2u; }
    const size_t kstep = (size_t)(BK * 2);
    const size_t hstep = (size_t)HALF * K * 2;
    const size_t tstep = 2 * hstep;
    const unsigned ldsw = (unsigned)wid * 1024u;
    const int aoff = lds_byte(wr * 64 + fr, fq * 8), boff = lds_byte(wc * 32 + fr, fq * 8);
#define PG8_SA(b, h) (((b) * 2 + (h)) * HTB)
#define PG8_SB(b, h) ((4 + (b) * 2 + (h)) * HTB)
#define PG8_STAGE(bufoff, gbase, voff) do { _Pragma("unroll") for (int _i = 0; _i < 2; ++_i) \
        __builtin_amdgcn_global_load_lds((const unsigned*)((const char*)(gbase) + (voff)[_i]), (PG8_LAS unsigned*)(lds + (bufoff) + ldsw + _i * 8192), 16, 0, 0); } while (0)
#define PG8_LDA(dst, b, h) do { _Pragma("unroll") for (int m = 0; m < 4; ++m) _Pragma("unroll") for (int k = 0; k < 2; ++k) dst[m][k] = *(const PG8_LAS bf16x8*)(lds + PG8_SA(b, h) + aoff + m * 2048 + k * 1024); } while (0)
#define PG8_LDB(dst, b, h) do { _Pragma("unroll") for (int n = 0; n < 2; ++n) _Pragma("unroll") for (int k = 0; k < 2; ++k) dst[n][k] = *(const PG8_LAS bf16x8*)(lds + PG8_SB(b, h) + boff + n * 2048 + k * 1024); } while (0)
#define PG8_MMA(ai, bj, At, Bt) do { __builtin_amdgcn_s_setprio(1); _Pragma("unroll") for (int m = 0; m < 4; ++m) _Pragma("unroll") for (int n = 0; n < 2; ++n) _Pragma("unroll") for (int k = 0; k < 2; ++k) \
        acc[ai][bj][m][n] = __builtin_amdgcn_mfma_f32_16x16x32_bf16(Bt[n][k], At[m][k], acc[ai][bj][m][n], 0, 0, 0); __builtin_amdgcn_s_setprio(0); } while (0)
#define PG8_WAIT_V(n) asm volatile("s_waitcnt vmcnt(" #n ")" ::: "memory")
#define PG8_WAIT_L(n) asm volatile("s_waitcnt lgkmcnt(" #n ")" ::: "memory")
#define PG8_BAR __builtin_amdgcn_s_barrier()
#define PG8_SCHED __builtin_amdgcn_sched_barrier(0)
    Unit cur, nxt; int ui = 0;
    if (!S.next(0, cur)) return;
    f32x4 acc[2][2][4][2];
#pragma unroll
    for (int a = 0; a < 2; ++a)
#pragma unroll
        for (int b = 0; b < 2; ++b)
#pragma unroll
            for (int m = 0; m < 4; ++m)
#pragma unroll
                for (int n = 0; n < 2; ++n) acc[a][b][m][n] = (f32x4){0.f, 0.f, 0.f, 0.f};
    bf16x8 At[4][2], B0[2][2], B1[2][2];
    const char* cA = (const char*)g.A + (size_t)cur.pm * tstep; const char* cB = (const char*)g.Bt + (size_t)cur.pn * tstep;
    S.a_ready(cur);
    if constexpr (SP2) {
        PG8_STAGE(PG8_SB(0, 0), cB, voffB); PG8_STAGE(PG8_SB(0, 1), cB + hstep, voffB); PG8_STAGE(PG8_SA(0, 0), cA, voffA); PG8_STAGE(PG8_SA(0, 1), cA + hstep, voffA);
        if (wr == 1) PG8_BAR;
        PG8_WAIT_V(2); PG8_BAR;
        PG8_STAGE(PG8_SB(1, 0), cB + kstep, voffB); PG8_STAGE(PG8_SA(1, 0), cA + kstep, voffA); PG8_STAGE(PG8_SB(1, 1), cB + hstep + kstep, voffB);
        PG8_WAIT_V(6); PG8_BAR;
    } else {
        PG8_STAGE(PG8_SB(0, 0), cB, voffB); PG8_STAGE(PG8_SA(0, 0), cA, voffA); PG8_STAGE(PG8_SB(0, 1), cB + hstep, voffB); PG8_STAGE(PG8_SA(0, 1), cA + hstep, voffA);
        if (wr == 1) PG8_BAR;
        PG8_WAIT_V(4); PG8_BAR;
        PG8_STAGE(PG8_SB(1, 0), cB + kstep, voffB); PG8_STAGE(PG8_SA(1, 0), cA + kstep, voffA); PG8_STAGE(PG8_SB(1, 1), cB + hstep + kstep, voffB);
        PG8_WAIT_V(6); PG8_BAR;
    }
    for (;;) {
        const bool has_next = S.next(ui + 1, nxt);
        const char* nA = has_next ? (const char*)g.A + (size_t)nxt.pm * tstep : cA; const char* nB = has_next ? (const char*)g.Bt + (size_t)nxt.pn * tstep : cB;
        for (int t = 0; t < nt; t += 2) {
            const bool last = (t == nt - 2);
            const char* a1 = cA + (size_t)(t + 1) * kstep;
            const char* a2 = last ? nA : cA + (size_t)(t + 2) * kstep; const char* b2 = last ? nB : cB + (size_t)(t + 2) * kstep;
            const char* a3 = a2 + kstep; const char* b3 = b2 + kstep;
            if (last && has_next) S.a_ready(nxt);
            if constexpr (SP2) {
            PG8_LDB(B0, 0, 0); PG8_LDB(B1, 0, 1); PG8_SCHED; PG8_LDA(At, 0, 0); PG8_STAGE(PG8_SA(1, 1), a1 + hstep, voffA);
            PG8_WAIT_V(8); PG8_WAIT_L(0); PG8_BAR; PG8_MMA(0, 0, At, B0); PG8_MMA(0, 1, At, B1); PG8_BAR; PG8_SCHED;
            PG8_LDA(At, 0, 1); PG8_STAGE(PG8_SB(0, 0), b2, voffB); PG8_STAGE(PG8_SB(0, 1), b2 + hstep, voffB); PG8_STAGE(PG8_SA(0, 0), a2, voffA);
            PG8_WAIT_V(8); PG8_WAIT_L(0); PG8_BAR; PG8_MMA(1, 0, At, B0); PG8_MMA(1, 1, At, B1); PG8_BAR; PG8_SCHED;
            PG8_LDB(B0, 1, 0); PG8_LDB(B1, 1, 1); PG8_SCHED; PG8_LDA(At, 1, 0); PG8_STAGE(PG8_SA(0, 1), a2 + hstep, voffA);
            PG8_WAIT_V(8); PG8_WAIT_L(0); PG8_BAR; PG8_MMA(0, 0, At, B0); PG8_MMA(0, 1, At, B1); PG8_BAR; PG8_SCHED;
            PG8_LDA(At, 1, 1); PG8_STAGE(PG8_SB(1, 0), b3, voffB); PG8_STAGE(PG8_SB(1, 1), b3 + hstep, voffB); PG8_STAGE(PG8_SA(1, 0), a3, voffA);
            PG8_WAIT_V(8); PG8_WAIT_L(0); PG8_BAR; PG8_MMA(1, 0, At, B0); PG8_MMA(1, 1, At, B1); PG8_BAR; PG8_SCHED;
            } else {
            PG8_LDB(B0, 0, 0); PG8_SCHED; PG8_LDA(At, 0, 0); PG8_STAGE(PG8_SA(1, 1), a1 + hstep, voffA);
            PG8_WAIT_L(8); PG8_BAR; PG8_WAIT_L(0); PG8_MMA(0, 0, At, B0); PG8_BAR; PG8_SCHED;
            PG8_LDB(B1, 0, 1); PG8_STAGE(PG8_SB(0, 0), b2, voffB);
            PG8_BAR; PG8_WAIT_L(0); PG8_MMA(0, 1, At, B1); PG8_BAR;
            PG8_LDA(At, 0, 1); PG8_STAGE(PG8_SA(0, 0), a2, voffA);
            PG8_BAR; PG8_WAIT_L(0); PG8_MMA(1, 0, At, B0); PG8_BAR; PG8_SCHED;
            PG8_STAGE(PG8_SB(0, 1), b2 + hstep, voffB);
            PG8_WAIT_V(6); PG8_BAR; PG8_MMA(1, 1, At, B1); PG8_BAR;
            PG8_LDB(B0, 1, 0); PG8_SCHED; PG8_LDA(At, 1, 0); PG8_STAGE(PG8_SA(0, 1), a2 + hstep, voffA);
            PG8_WAIT_L(8); PG8_BAR; PG8_WAIT_L(0); PG8_MMA(0, 0, At, B0); PG8_BAR; PG8_SCHED;
            PG8_LDB(B1, 1, 1); PG8_STAGE(PG8_SB(1, 0), b3, voffB);
            PG8_BAR; PG8_WAIT_L(0); PG8_MMA(0, 1, At, B1); PG8_BAR;
            PG8_LDA(At, 1, 1); PG8_STAGE(PG8_SA(1, 0), a3, voffA);
            PG8_BAR; PG8_WAIT_L(0); PG8_MMA(1, 0, At, B0); PG8_BAR; PG8_SCHED;
            PG8_STAGE(PG8_SB(1, 1), b3 + hstep, voffB);
            PG8_WAIT_V(6); PG8_BAR; PG8_MMA(1, 1, At, B1); PG8_BAR;
            }
        }
        if constexpr (ALIGN_EPI) { if (wr == 0) PG8_BAR; }
        if constexpr (!Epi::AFTER_DRAIN) { E(acc, cur, wr, wc, fr, fq); S.done(cur); }
        if (!has_next) break;
#pragma unroll
        for (int a = 0; a < 2; ++a)
#pragma unroll
            for (int b = 0; b < 2; ++b)
#pragma unroll
                for (int m = 0; m < 4; ++m)
#pragma unroll
                    for (int n = 0; n < 2; ++n) acc[a][b][m][n] = (f32x4){0.f, 0.f, 0.f, 0.f};
        cur = nxt; cA = nA; cB = nB; ++ui;
        if constexpr (ALIGN_EPI) { if (wr == 1) PG8_BAR; }
    }
    PG8_WAIT_V(0);
    if constexpr (!ALIGN_EPI) { if (wr == 0) PG8_BAR; }
    PG8_BAR;
    if constexpr (Epi::AFTER_DRAIN) { E.fused(acc, cur, wr, wc, fr, fq, lds, wid, lane); S.done(cur); }
#undef PG8_SA
#undef PG8_SB
#undef PG8_STAGE
#undef PG8_LDA
#undef PG8_LDB
#undef PG8_MMA
#undef PG8_WAIT_V
#undef PG8_WAIT_L
#undef PG8_BAR
#undef PG8_SCHED
}
}
#define GAS __attribute__((address_space(1)))
#define LAS __attribute__((address_space(3)))
typedef unsigned short bf16;
typedef unsigned v4u __attribute__((ext_vector_type(4)));
typedef float f32x4 __attribute__((ext_vector_type(4)));
typedef short bf16x8 __attribute__((ext_vector_type(8)));
typedef GAS unsigned gu32;
typedef GAS unsigned long long gu64;
#define RLX_AGENT __ATOMIC_RELAXED, __HIP_MEMORY_SCOPE_AGENT
#define LDS_WAIT() asm volatile("s_waitcnt lgkmcnt(0)" ::: "memory")
#define VM_WAIT() asm volatile("s_waitcnt vmcnt(0)" ::: "memory")
__device__ __forceinline__ unsigned long long rt() { return __builtin_amdgcn_s_memrealtime(); }
__device__ __forceinline__ unsigned f2bf(float f) { unsigned u = __builtin_bit_cast(unsigned, f); return (u + 0x7fffu + ((u >> 16) & 1u)) >> 16; }
__device__ __forceinline__ unsigned pk2(float lo, float hi) { return f2bf(lo) | (f2bf(hi) << 16); }

#define XB_TMO      128
#define XB_XCNT(j)  (256  + 64 * (j))
#define XB_XSUB(j)  (1280 + 64 * (j))
#define XB_XGEN(j)  (2304 + 64 * (j))
#define XB_TOP      3328
#define XB_TOPGEN   3392
#define XCD_BAR_WORDS 3456
#define XB_SPIN_CAP (1u << 18)

__device__ __forceinline__ unsigned xb_ld(unsigned* p)              { return __hip_atomic_load(p, __ATOMIC_RELAXED, __HIP_MEMORY_SCOPE_AGENT); }
__device__ __forceinline__ unsigned xb_add(unsigned* p, unsigned v) { return __hip_atomic_fetch_add(p, v, __ATOMIC_RELAXED, __HIP_MEMORY_SCOPE_AGENT); }
__device__ __forceinline__ unsigned xb_xcc_id() { return (unsigned)__builtin_amdgcn_s_getreg((3 << 11) | 20) & 0xFu; }
#define XB_SPIN(cond, bar) do { unsigned _sp = 0; while (cond) { __builtin_amdgcn_s_sleep(1); \
    if ((++_sp & 255u) == 0u) { if (xb_ld(&(bar)[XB_TMO])) break; if (_sp > XB_SPIN_CAP) { atomicAdd(&(bar)[XB_TMO], 1u); break; } } } } while (0)

struct XcdBarrier {
    unsigned* bar; unsigned x;
    volatile LAS unsigned* st;
};

__device__ __forceinline__ XcdBarrier xcd_barrier_post(unsigned* bar, volatile LAS unsigned* st) {
    XcdBarrier b; b.bar = bar; b.x = xb_xcc_id(); b.st = st;
    if (threadIdx.x == 0) (void)xb_add(&bar[XB_XCNT(b.x)], 1u);
    return b;
}
__device__ __forceinline__ void xcd_barrier_complete(unsigned* bar, unsigned x, unsigned& nloc, unsigned& nx) {
    const unsigned G = gridDim.x * gridDim.y * gridDim.z;
    unsigned sum, cnt, mine, sp = 0u;
    for (;;) {
        sum = 0u; cnt = 0u; mine = 0u;
#pragma unroll
        for (unsigned j = 0; j < 16; ++j) { const unsigned c = xb_ld(&bar[XB_XCNT(j)]); sum += c; cnt += (c > 0u) ? 1u : 0u; mine = (j == x) ? c : mine; }
        if (sum == G) break;
        __builtin_amdgcn_s_sleep(1);
        if ((++sp & 255u) == 0u) { if (xb_ld(&bar[XB_TMO])) break; if (sp > XB_SPIN_CAP) { atomicAdd(&bar[XB_TMO], 1u); break; } }
    }
    nloc = mine > 0u ? mine : 1u; nx = cnt > 0u ? cnt : 1u;
}

__device__ __forceinline__ void xcd_barrier(const XcdBarrier& b) {
    asm volatile("s_waitcnt vmcnt(0)" ::: "memory");
    __syncthreads();
    if (threadIdx.x == 0) {
        unsigned* bar = b.bar;
        __builtin_amdgcn_s_waitcnt(0);
        unsigned nloc = b.st[0], nx = b.st[1];
        if (nloc == 0u) { xcd_barrier_complete(bar, b.x, nloc, nx); b.st[0] = nloc; b.st[1] = nx; }
        const unsigned old = xb_add(&bar[XB_XSUB(b.x)], 1u);
        const unsigned gen = old / nloc;
        if (old + 1u == (gen + 1u) * nloc) {
            __builtin_amdgcn_fence(__ATOMIC_RELEASE, "agent");
            asm volatile("s_waitcnt vmcnt(0)" ::: "memory");
            const unsigned og = xb_add(&bar[XB_TOP], 1u);
            const unsigned tg = og / nx;
            if (og + 1u == (tg + 1u) * nx) xb_add(&bar[XB_TOPGEN], 1u);
            else XB_SPIN(xb_ld(&bar[XB_TOPGEN]) == tg, bar);
            __builtin_amdgcn_fence(__ATOMIC_ACQUIRE, "agent");
            xb_add(&bar[XB_XGEN(b.x)], 1u);
            asm volatile("s_waitcnt vmcnt(0)" ::: "memory");
        } else {
            XB_SPIN(xb_ld(&bar[XB_XGEN(b.x)]) == gen, bar);
            __builtin_amdgcn_fence(__ATOMIC_ACQUIRE, "agent");
            asm volatile("s_waitcnt vmcnt(0)" ::: "memory");
        }
    }
    __syncthreads();
}

constexpr int NWAVES = 8;
constexpr int NB = 8, SEQ = 2048, D = 1024, M = NB * SEQ, FF = 2816, NFF2 = 2 * FF, NH = 8, CW = 31;
constexpr float EPS = 1e-6f;
constexpr float LOG2E = 1.4426950408889634f;
constexpr float QSCALE = 0.125f * LOG2E;
constexpr int N_PHASES = 22;

constexpr size_t MiB = 1u << 20;
constexpr size_t WS_CTL = 0, CTL_ZERO_BYTES = 64 * 1024;
constexpr size_t WS_SSQ = 1 * MiB;
constexpr size_t CONF_W_ELEMS = (size_t)2048 * 1024 + (size_t)1024 * 1024 + (size_t)5632 * 1024 + (size_t)1024 * 2816;
constexpr size_t ATT_W_ELEMS  = (size_t)3072 * 1024 + (size_t)1024 * 1024 + (size_t)5632 * 1024 + (size_t)1024 * 2816;
constexpr size_t CW_PW1 = 0, CW_PW2 = (size_t)2048 * 1024, CW_W13 = CW_PW2 + (size_t)1024 * 1024, CW_W2 = CW_W13 + (size_t)5632 * 1024;
constexpr size_t AW_QKV = 0, AW_WO = (size_t)3072 * 1024, AW_W13 = AW_WO + (size_t)1024 * 1024, AW_W2 = AW_W13 + (size_t)5632 * 1024;
constexpr size_t WS_WC = 2 * MiB;
constexpr size_t WS_WA = WS_WC + 2 * CONF_W_ELEMS * 2;
constexpr size_t WS_XB = WS_WA + 2 * ATT_W_ELEMS * 2;
constexpr size_t WS_V  = WS_XB + 32 * MiB;
constexpr size_t WS_R  = WS_V + 32 * MiB;
constexpr size_t WS_K  = WS_WC;
constexpr size_t WS_H = WS_R, WS_G = WS_R, WS_U = WS_R + 32 * MiB, WS_QO = WS_R, WS_O0 = WS_R + 32 * MiB;
constexpr size_t WS_END = WS_R + 96 * MiB;
static_assert(WS_WA == 47 * MiB && WS_XB == 96 * MiB && WS_R == 160 * MiB && WS_END == 256 * MiB, "d_ws map");
static_assert((size_t)M * FF * 2 <= 96 * MiB && WS_K + 32 * MiB <= WS_WA, "d_ws overlays");

constexpr int RING_OFF = 0, RING_BYTES = 131072;
constexpr int LDSCTL_OFF = RING_BYTES, MISC_OFF = LDSCTL_OFF + 320;
constexpr int LDS_BYTES = 147456;

typedef float f32x16 __attribute__((ext_vector_type(16)));
typedef short s16x4 __attribute__((ext_vector_type(4)));
typedef float f32x2 __attribute__((ext_vector_type(2)));
typedef unsigned u32x2 __attribute__((ext_vector_type(2)));
typedef unsigned u32x4 __attribute__((ext_vector_type(4)));

struct Args { const float* in[26]; float* out; unsigned char* ws; int ph_lo, ph_hi; float lam_init2, lam_init3; };
struct Frame {
    LAS unsigned char* lds; volatile LAS unsigned* MISC; gu32* ctl;
    int tid, lane, wave, vcu, G;
};
__device__ __forceinline__ float wave_sum(float v) {
#pragma unroll
    for (int o = 1; o < 64; o <<= 1) v += __shfl_xor(v, o);
    return v;
}
__device__ __forceinline__ float bf_lo(unsigned v) { return __uint_as_float(v << 16); }
__device__ __forceinline__ float bf_hi(unsigned v) { return __uint_as_float(v & 0xffff0000u); }

__device__ __forceinline__ void p0_transpose_item(const float* W, int ld, int K, int nblk, const float* gain, bf16* WT, int ilv, int row_off, LAS float* scr, int item, int lane) {
    const int kb = item / nblk, nb = item % nblk, k0 = 64 * kb, n0 = 32 * nb;
    const GAS float* src = (const GAS float*)W + (size_t)(k0 + (lane >> 5)) * ld + n0 + (lane & 31);
    float v[32];
#pragma unroll
    for (int i = 0; i < 32; ++i) v[i] = src[(size_t)(2 * i) * ld];
    const int c = lane & 7;
    f32x4 g0 = (f32x4){1.f, 1.f, 1.f, 1.f}, g1 = g0;
    if (gain) { g0 = *(const GAS f32x4*)(gain + k0 + 8 * c); g1 = *(const GAS f32x4*)(gain + k0 + 8 * c + 4); }
#pragma unroll
    for (int i = 0; i < 32; ++i) scr[(2 * i + (lane >> 5)) * 33 + (lane & 31)] = v[i];
    LDS_WAIT(); asm volatile("" ::: "memory");
    const int d0 = (ilv ? (((n0 >> 7) << 8) + (n0 & 127)) : n0) + row_off;
#pragma unroll
    for (int j = 0; j < 4; ++j) { const int n = (lane >> 3) + 8 * j; const LAS float* s = scr + (8 * c) * 33 + n;
        v4u o; o.x = pk2(s[0 * 33] * g0[0], s[1 * 33] * g0[1]); o.y = pk2(s[2 * 33] * g0[2], s[3 * 33] * g0[3]); o.z = pk2(s[4 * 33] * g1[0], s[5 * 33] * g1[1]); o.w = pk2(s[6 * 33] * g1[2], s[7 * 33] * g1[3]);
        *(GAS v4u*)(WT + (size_t)(d0 + n) * K + k0 + 8 * c) = o; }
    LDS_WAIT(); asm volatile("" ::: "memory");
}
__device__ __forceinline__ void p0_prologue(Frame& F, const Args& A) {
    LAS float* scr = (LAS float*)(F.lds + RING_OFF + F.wave * 16384);
    const int gw = F.vcu * NWAVES + F.wave, NGW = F.G * NWAVES;
    bf16* wsb = (bf16*)A.ws;
    for (int it0 = gw; it0 < 4 * 6272; it0 += NGW) {
        const int it = __builtin_amdgcn_readfirstlane(it0);
        const int L = it / 6272; int r = it % 6272; int slot;
        if (r < 2048) { slot = r >> 9; r &= 511; } else { r -= 2048; slot = 4 + r / 1408; r %= 1408; }
        const float* W; int ld, K, nblk, ilv = 0, row_off = 0; const float* gain = nullptr; bf16* dst;
        bf16* wl = (L < 2) ? wsb + WS_WC / 2 + (size_t)L * CONF_W_ELEMS : wsb + WS_WA / 2 + (size_t)(L - 2) * ATT_W_ELEMS;
        if (slot >= 4) {
            if (slot == 6) { W = A.in[24] + (size_t)L * FF * D; ld = D; K = FF; nblk = D / 32; dst = wl + (L < 2 ? CW_W2 : AW_W2); }
            else { W = (slot == 4 ? A.in[22] : A.in[23]) + (size_t)L * D * FF; ld = FF; K = D; nblk = FF / 32; ilv = 1; row_off = (slot == 4) ? 0 : 128; gain = A.in[21] + L * D; dst = wl + (L < 2 ? CW_W13 : AW_W13); }
        } else if (L < 2) {
            if (slot == 3) continue;
            if (slot == 2) { W = A.in[8] + (size_t)L * D * D; ld = D; K = D; nblk = D / 32; dst = wl + CW_PW2; }
            else { W = A.in[2] + (size_t)L * D * 2 * D + (slot == 1 ? D : 0); ld = 2 * D; K = D; nblk = D / 32; ilv = 1; row_off = (slot == 1) ? 128 : 0; gain = A.in[1] + L * D; dst = wl + CW_PW1; }
        } else {
            const int j = L - 2;
            if (slot == 0) { W = A.in[14] + (size_t)j * D * D; gain = A.in[13] + j * D; dst = wl + AW_QKV; }
            else if (slot == 1) { if (j) continue; W = A.in[11]; gain = A.in[10]; dst = wl + AW_QKV; row_off = 1024; }
            else if (slot == 2) { if (j) continue; W = A.in[12]; gain = A.in[10]; dst = wl + AW_QKV; row_off = 2048; }
            else { W = A.in[20] + (size_t)j * D * D; dst = wl + AW_WO; }
            ld = D; K = D; nblk = D / 32;
        }
        p0_transpose_item(W, ld, K, nblk, gain, dst, ilv, row_off, scr, r, F.lane);
    }
    const float* x = A.in[0]; bf16* XB = (bf16*)(A.ws + WS_XB); float* ssq = (float*)(A.ws + WS_SSQ);
    for (int m0 = gw * 4; m0 < M; m0 += NGW * 4) {
        f32x4 v[4][4];
#pragma unroll
        for (int q = 0; q < 4; ++q)
#pragma unroll
            for (int j = 0; j < 4; ++j) v[q][j] = *((const GAS f32x4*)(x + (size_t)(m0 + q) * D) + F.lane + 64 * j);
#pragma unroll
        for (int q = 0; q < 4; ++q) { float s = 0.f;
#pragma unroll
            for (int j = 0; j < 4; ++j) s += (v[q][j].x * v[q][j].x + v[q][j].y * v[q][j].y) + (v[q][j].z * v[q][j].z + v[q][j].w * v[q][j].w);
            s = wave_sum(s);
            GAS unsigned long long* o8 = (GAS unsigned long long*)(XB + (size_t)(m0 + q) * D) + F.lane;
#pragma unroll
            for (int j = 0; j < 4; ++j) o8[64 * j] = (unsigned long long)pk2(v[q][j].x, v[q][j].y) | ((unsigned long long)pk2(v[q][j].z, v[q][j].w) << 32);
            if (F.lane == 0) *(GAS f32x4*)(ssq + (size_t)(m0 + q) * 4) = (f32x4){s, 0.f, 0.f, 0.f}; }
    }
}
__device__ __forceinline__ void final_phase(Frame& F, float* X, const float* g) {
    const int gw = F.vcu * NWAVES + F.wave, NGW = F.G * NWAVES;
    f32x4 gv[4];
#pragma unroll
    for (int j = 0; j < 4; ++j) gv[j] = *((const GAS f32x4*)g + F.lane + 64 * j);
    for (int m0 = gw * 4; m0 < M; m0 += NGW * 4) {
        f32x4 v[4][4];
#pragma unroll
        for (int q = 0; q < 4; ++q)
#pragma unroll
            for (int j = 0; j < 4; ++j) v[q][j] = *((const GAS f32x4*)(X + (size_t)(m0 + q) * D) + F.lane + 64 * j);
#pragma unroll
        for (int q = 0; q < 4; ++q) { float s = 0.f;
#pragma unroll
            for (int j = 0; j < 4; ++j) s += (v[q][j].x * v[q][j].x + v[q][j].y * v[q][j].y) + (v[q][j].z * v[q][j].z + v[q][j].w * v[q][j].w);
            const float rs = 1.0f / sqrtf(wave_sum(s) * (1.0f / D) + EPS);
#pragma unroll
            for (int j = 0; j < 4; ++j) *((GAS f32x4*)(X + (size_t)(m0 + q) * D) + F.lane + 64 * j) = v[q][j] * rs * gv[j]; }
    }
}
__device__ __forceinline__ void conv_phase(Frame& F, const bf16* G, bf16* U, const float* dww, const float* dwb, const float* lng, const float* lnb) {
    LAS float* red = (LAS float*)(F.lds + RING_OFF);
    const int c0 = 2 * F.tid;
    f32x2 w[CW];
#pragma unroll
    for (int j = 0; j < CW; ++j) w[j] = *(const GAS f32x2*)(dww + j * D + c0);
    const f32x2 bb = *(const GAS f32x2*)(dwb + c0), gg = *(const GAS f32x2*)(lng + c0), be = *(const GAS f32x2*)(lnb + c0);
    for (int unit = F.vcu; unit < M / 32; unit += F.G) {
        const int row0 = unit * 32; const bool head = ((row0 & (SEQ - 1)) == 0);
        f32x2 acc[32];
#pragma unroll
        for (int p = 0; p < 32; ++p) acc[p] = (f32x2){0.f, 0.f};
        unsigned gin[62];
        { const GAS unsigned* gp = (const GAS unsigned*)(G + (size_t)(head ? row0 : row0 - 30) * D + c0);
#pragma unroll
          for (int i = 0; i < 62; ++i) gin[i] = gp[(size_t)(head ? (i < 30 ? 0 : i - 30) : i) * (D / 2)]; }
        const float hmsk = head ? 0.0f : 1.0f;
#pragma unroll
        for (int i = 0; i < 62; ++i) {
            const float msk = (i < 30) ? hmsk : 1.0f;
            const unsigned v = gin[i];
            const f32x2 g = (f32x2){bf_lo(v) * msk, bf_hi(v) * msk};
#pragma unroll
            for (int p = (i > 30 ? i - 30 : 0); p <= (i < 31 ? i : 31); ++p) acc[p] += w[i - p] * g;
        }
        float v[64];
#pragma unroll
        for (int p = 0; p < 32; ++p) { acc[p] += bb; v[p] = acc[p].x + acc[p].y; v[32 + p] = acc[p].x * acc[p].x + acc[p].y * acc[p].y; }
#pragma unroll
        for (int o = 32, n = 32; o >= 1; o >>= 1, n >>= 1) {
            const bool up = (F.lane & o) != 0;
#pragma unroll
            for (int i = 0; i < n; ++i) { const float send = up ? v[i] : v[i + n]; const float keep = up ? v[i + n] : v[i]; v[i] = keep + __shfl_xor(send, o); }
        }
        __syncthreads();
        red[F.wave * 64 + F.lane] = v[0];
        __syncthreads();
        if (F.tid < 64) { float t = 0.f;
#pragma unroll
            for (int wv = 0; wv < 8; ++wv) t += red[wv * 64 + F.tid];
            red[512 + F.tid] = t; }
        __syncthreads();
#pragma unroll
        for (int p = 0; p < 32; ++p) {
            const float mean = red[512 + p] * (1.0f / D), var = red[512 + 32 + p] * (1.0f / D) - mean * mean, rs = 1.0f / sqrtf(fmaxf(var, 0.f) + EPS);
            const f32x2 y = (acc[p] - mean) * rs * gg + be;
            const float s0 = y.x * pg8::sigmoidf_(y.x), s1 = y.y * pg8::sigmoidf_(y.y);
            *(GAS unsigned*)(U + (size_t)(row0 + p) * D + c0) = pk2(s0, s1);
        }
    }
}
__device__ __forceinline__ int crow(int r, int hi) { return (r & 3) + 8 * (r >> 2) + 4 * hi; }
constexpr int ATT_BUF = 24576;
__device__ __forceinline__ void attn_unit(Frame& F, int b, int h, int qb, const bf16* Qb, const bf16* Kb, const bf16* Vb, bf16* Ob, float* O0, float lam, float lam_init, const float* subg) {
    const int lane = F.lane, r32 = lane & 31, hi = lane >> 5, wid = F.wave;
    LAS unsigned char* lds = F.lds + RING_OFF;
    LAS float* wsf = (LAS float*)(lds + 2 * ATT_BUF) + wid * 64;
    const size_t rowbase = (size_t)b * SEQ; const int q0 = qb * 256, NT = 4 * (qb + 1);
    const int tq = q0 + 32 * wid + r32;
    const float sl2 = LOG2E * __builtin_amdgcn_exp2f(-(float)(h + 1));
    const int unit_lin = (b * NH + h) * 8 + qb;
    float* park = O0 + ((size_t)(unit_lin * 8 + wid) * 64 + lane) * 64;
    const int kdst = wid * 1024 + lane * 16;
    const LAS unsigned char* kp0 = lds + hi * 1024 + r32 * 16;
    const LAS unsigned char* vp0 = lds + 8192 + ((lane >> 4) & 1) * 32 + (lane & 3) * 8 + (4 * hi + ((lane & 15) >> 2)) * 64;
#pragma unroll 1
    for (int c = 0; c < 2; ++c) {
        const bf16* Qw = Qb + (rowbase + q0 + wid * 32) * D + (2 * h + c) * 64;
        bf16x8 qr[4];
#pragma unroll
        for (int d0 = 0; d0 < 4; ++d0) qr[d0] = *(const GAS bf16x8*)(Qw + (size_t)r32 * D + d0 * 16 + hi * 8);
        const bf16* ksrc = Kb + (rowbase + lane) * D + (2 * h + c) * 64 + wid * 8;
        const bf16* vsrc0 = Vb + (rowbase + 16 * (wid & 3) + (lane >> 2)) * D + h * 128 + (wid >> 2) * 32 + (lane & 3) * 8;
        const bf16* vsrc1 = vsrc0 + 64;
        f32x16 o[4];
#pragma unroll
        for (int d0 = 0; d0 < 4; ++d0) o[d0] = (f32x16){};
        float m_run = -1e30f, l_run = 0.f;
        { const v4u k0 = *(const GAS v4u*)ksrc, v0 = *(const GAS v4u*)vsrc0, v1 = *(const GAS v4u*)vsrc1;
          *(LAS v4u*)(lds + kdst) = k0; *(LAS v4u*)(lds + 8192 + kdst) = v0; *(LAS v4u*)(lds + 8192 + 8192 + kdst) = v1; }
        __syncthreads();
#pragma unroll 1
        for (int t = 0; t < NT; ++t) {
            const int bo = (t & 1) * ATT_BUF, bn = ((t + 1) & 1) * ATT_BUF; const bool more = (t + 1 < NT);
            v4u kn = {}, vn0 = {}, vn1 = {};
            if (more) { const size_t go = (size_t)(t + 1) * 64 * D; kn = *(const GAS v4u*)(ksrc + go); vn0 = *(const GAS v4u*)(vsrc0 + go); vn1 = *(const GAS v4u*)(vsrc1 + go); }
            const float cb = sl2 * (float)(64 * t + 4 * hi - tq);
            f32x16 p0, p1;
#pragma unroll
            for (int r = 0; r < 16; ++r) { p0[r] = cb; p1[r] = cb + 32.0f * sl2; }
#pragma unroll
            for (int d0 = 0; d0 < 4; ++d0) {
                const bf16x8 k0 = *(const LAS bf16x8*)(kp0 + bo + d0 * 2048), k1 = *(const LAS bf16x8*)(kp0 + bo + d0 * 2048 + 512);
                p0 = __builtin_amdgcn_mfma_f32_32x32x16_bf16(k0, qr[d0], p0, 0, 0, 0); p1 = __builtin_amdgcn_mfma_f32_32x32x16_bf16(k1, qr[d0], p1, 0, 0, 0); }
#pragma unroll
            for (int r = 0; r < 16; ++r) { const float kr = (float)((r & 3) + 8 * (r >> 2)); p0[r] = __builtin_fmaf(sl2, kr, p0[r]); p1[r] = __builtin_fmaf(sl2, kr, p1[r]); }
            if (t >= NT - 4) { const int kb = 64 * t + 4 * hi;
#pragma unroll
                for (int r = 0; r < 16; ++r) { const int kv = kb + (r & 3) + 8 * (r >> 2); if (kv > tq) p0[r] = -INFINITY; if (kv + 32 > tq) p1[r] = -INFINITY; } }
            float mt = fmaxf(p0[0], p1[0]);
#pragma unroll
            for (int r = 1; r < 16; ++r) mt = fmaxf(mt, fmaxf(p0[r], p1[r]));
            mt = fmaxf(mt, __shfl_xor(mt, 32));
            const float m_new = fmaxf(m_run, mt), alpha = __builtin_amdgcn_exp2f(m_run - m_new); m_run = m_new;
            float ls = 0.f;
#pragma unroll
            for (int r = 0; r < 16; ++r) { p0[r] = __builtin_amdgcn_exp2f(p0[r] - m_new); p1[r] = __builtin_amdgcn_exp2f(p1[r] - m_new); ls += p0[r] + p1[r]; }
            l_run = l_run * alpha + ls;
            if (hi == 0) wsf[r32] = alpha;
            u32x4 pw[4];
#pragma unroll
            for (int k = 0; k < 4; ++k) { pw[0][k] = pg8::cvt_pk_bf16(p0[2 * k], p0[2 * k + 1]); pw[1][k] = pg8::cvt_pk_bf16(p0[8 + 2 * k], p0[8 + 2 * k + 1]);
                                           pw[2][k] = pg8::cvt_pk_bf16(p1[2 * k], p1[2 * k + 1]); pw[3][k] = pg8::cvt_pk_bf16(p1[8 + 2 * k], p1[8 + 2 * k + 1]); }
            float al[16];
#pragma unroll
            for (int r = 0; r < 16; ++r) al[r] = wsf[crow(r, hi)];
#pragma unroll
            for (int d0 = 0; d0 < 4; ++d0) {
#pragma unroll
                for (int r = 0; r < 16; ++r) o[d0][r] *= al[r];
#pragma unroll
                for (int ks = 0; ks < 4; ++ks) {
                    const s16x4 lo = __builtin_bit_cast(s16x4, __builtin_amdgcn_ds_read_tr16_b64_v4i16((LAS s16x4*)(vp0 + bo + d0 * 4096 + ks * 1024)));
                    const s16x4 hh = __builtin_bit_cast(s16x4, __builtin_amdgcn_ds_read_tr16_b64_v4i16((LAS s16x4*)(vp0 + bo + d0 * 4096 + ks * 1024 + 512)));
                    const bf16x8 vf = (bf16x8){lo[0], lo[1], lo[2], lo[3], hh[0], hh[1], hh[2], hh[3]};
                    o[d0] = __builtin_amdgcn_mfma_f32_32x32x16_bf16(__builtin_bit_cast(bf16x8, pw[ks]), vf, o[d0], 0, 0, 0); } }
            if (more) { *(LAS v4u*)(lds + bn + kdst) = kn; *(LAS v4u*)(lds + bn + 8192 + kdst) = vn0; *(LAS v4u*)(lds + bn + 16384 + kdst) = vn1; }
            __syncthreads();
        }
        l_run += __shfl_xor(l_run, 32);
        if (hi == 0) wsf[32 + r32] = l_run;
        float rl[16];
#pragma unroll
        for (int r = 0; r < 16; ++r) rl[r] = 1.0f / wsf[32 + crow(r, hi)];
        if (c == 0) {
#pragma unroll
            for (int d0 = 0; d0 < 4; ++d0)
#pragma unroll
                for (int q = 0; q < 4; ++q) *(GAS f32x4*)(park + d0 * 16 + q * 4) = (f32x4){o[d0][4 * q] * rl[4 * q], o[d0][4 * q + 1] * rl[4 * q + 1], o[d0][4 * q + 2] * rl[4 * q + 2], o[d0][4 * q + 3] * rl[4 * q + 3]};
        } else {
            asm volatile("s_waitcnt vmcnt(0)" ::: "memory");
            float ss[16];
#pragma unroll
            for (int r = 0; r < 16; ++r) ss[r] = 0.f;
#pragma unroll
            for (int d0 = 0; d0 < 4; ++d0)
#pragma unroll
                for (int q = 0; q < 4; ++q) { const f32x4 pk = *(const GAS f32x4*)(park + d0 * 16 + q * 4);
#pragma unroll
                    for (int i = 0; i < 4; ++i) { const int r = 4 * q + i; const float v = pk[i] - lam * (o[d0][r] * rl[r]); o[d0][r] = v; ss[r] += v * v; } }
#pragma unroll
            for (int r = 0; r < 16; ++r) {
#pragma unroll
                for (int o2 = 1; o2 < 32; o2 <<= 1) ss[r] += __shfl_xor(ss[r], o2);
                ss[r] = (1.0f - lam_init) / sqrtf(ss[r] * (1.0f / 128.0f) + EPS); }
            float gsub[4];
#pragma unroll
            for (int d0 = 0; d0 < 4; ++d0) gsub[d0] = subg[32 * d0 + r32];
            bf16* Ow = Ob + (rowbase + q0 + wid * 32 + 4 * hi + 2) * D + h * 128 + r32;
#pragma unroll
            for (int g = 0; g < 4; ++g) { asm volatile("" : "+v"(Ow));
#pragma unroll
                for (int i = 0; i < 4; ++i)
#pragma unroll
                    for (int d0 = 0; d0 < 4; ++d0) Ow[(i - 2) * D + 32 * d0] = (bf16)f2bf(o[d0][4 * g + i] * ss[4 * g + i] * gsub[d0]);
                Ow += 8 * D; }
        }
        __syncthreads();
    }
}
__device__ __forceinline__ void attn_phase(Frame& F, const Args& A, int j, float lam_init) {
    const bf16* Qb = (const bf16*)(A.ws + WS_QO); const bf16* Kb = (const bf16*)(A.ws + WS_K); const bf16* Vb = (const bf16*)(A.ws + WS_V);
    bf16* Ob = (bf16*)(A.ws + WS_QO); float* O0 = (float*)(A.ws + WS_O0);
    const float a = wave_sum(A.in[15][j * 64 + F.lane] * A.in[16][j * 64 + F.lane]), b2 = wave_sum(A.in[17][j * 64 + F.lane] * A.in[18][j * 64 + F.lane]);
    const float lam = expf(a) - expf(b2) + lam_init;
    const float* subg = A.in[19] + j * 128;
    for (int w = 2 * F.vcu; w < NB * NH * 8; w += 2 * F.G) {
#pragma unroll 1
        for (int e = 0; e < 2; ++e) { const int ww = w + e, bh = ww >> 3, k = ww & 7, qb = (k & 1) ? 7 - (k >> 1) : (k >> 1);
            attn_unit(F, bh >> 3, bh & 7, qb, Qb, Kb, Vb, Ob, O0, lam, lam_init, subg); }
    }
}

__global__ void __launch_bounds__(NWAVES * 64, 2) yoco_fwd(Args args) {
    extern __shared__ __attribute__((aligned(16))) unsigned char lds_raw[];
    Frame F;
    F.lds = (LAS unsigned char*)lds_raw;
    F.MISC = (volatile LAS unsigned*)(F.lds + MISC_OFF);
    F.tid = threadIdx.x; F.lane = F.tid & 63; F.wave = __builtin_amdgcn_readfirstlane(F.tid >> 6);
    F.G = gridDim.x; { const int bx = blockIdx.x; F.vcu = (F.G % 8 == 0) ? (bx % 8) * (F.G / 8) + bx / 8 : bx; }
    unsigned char* ws = args.ws;
    F.ctl = (gu32*)(ws + WS_CTL);
    for (int u = F.tid; u < (LDS_BYTES - LDSCTL_OFF) / 4; u += NWAVES * 64) ((LAS unsigned*)(F.lds + LDSCTL_OFF))[u] = 0u;
    __syncthreads();
    const int lo = args.ph_lo, hi = args.ph_hi;
    XcdBarrier bar; bar.bar = (unsigned*)F.ctl; bar.x = 0; bar.st = nullptr;
    if (hi - lo > 1) bar = xcd_barrier_post((unsigned*)F.ctl, F.MISC + 8);

    bf16* wsb = (bf16*)ws;
    bf16* XB = (bf16*)(ws + WS_XB); float* SSQ = (float*)(ws + WS_SSQ); float* X = args.out;
#pragma unroll 1
    for (int ph = lo; ph < hi; ++ph) {
#if PROBE_REP
      int kind_ = 0; if (ph == 0) kind_ = 0; else if (ph == N_PHASES - 1) kind_ = 15; else { const int L_ = (ph - 1) / 5, k_ = (ph - 1) % 5; kind_ = (k_ == 0) ? (L_ < 2 ? 1 : 3) : (k_ == 1) ? (L_ < 2 ? 2 : 4) : (k_ == 3) ? 5 : 15; }
      const int reps_ = 1 + ((PROBE_REP >> kind_) & 1);
#pragma unroll 1
      for (int rep_ = 0; rep_ < reps_; ++rep_) {
        if (rep_) xcd_barrier(bar);
#endif
        { int t_ = threadIdx.x; asm volatile("" : "+v"(t_)); F.tid = t_; F.lane = t_ & 63; F.wave = __builtin_amdgcn_readfirstlane(t_ >> 6); }
        if (ph == 0) p0_prologue(F, args);
        else if (ph == N_PHASES - 1) final_phase(F, X, args.in[25]);
        else {
            const int L = (ph - 1) / 5, k = (ph - 1) % 5;
            bf16* wl = (L < 2) ? wsb + WS_WC / 2 + (size_t)L * CONF_W_ELEMS : wsb + WS_WA / 2 + (size_t)(L - 2) * ATT_W_ELEMS;
            if (k == 0 && L < 2) {
                pg8::Gemm g{XB, wl + CW_PW1, M, 2 * D, D}; pg8::StaticOrder S; S.init(M, 2 * D, F.G, (int)blockIdx.x);
                pg8::EpiGate<0> E{(bf16*)(ws + WS_G), D, SSQ, args.in[3] + L * 2 * D};
                pg8::gemm_phase<pg8::EpiGate<0>, pg8::StaticOrder, true, true>(F.lds + RING_OFF, g, S, E);
            } else if (k == 0) {
                const int N = (L == 2) ? 3 * D : D;
                pg8::Gemm g{XB, wl + AW_QKV, M, N, D}; pg8::StaticOrder S; S.init(M, N, F.G, (int)blockIdx.x);
                typedef pg8::EpiQKV<WS_QO, WS_K, WS_V> EQ; EQ E{ws, SSQ, QSCALE};
                pg8::gemm_phase<EQ, pg8::StaticOrder, true, true>(F.lds + RING_OFF, g, S, E);
            } else if (k == 1 && L < 2) {
                conv_phase(F, (const bf16*)(ws + WS_G), (bf16*)(ws + WS_U), args.in[4] + L * CW * D, args.in[5] + L * D, args.in[6] + L * D, args.in[7] + L * D);
            } else if (k == 1) {
                attn_phase(F, args, L - 2, L == 2 ? args.lam_init2 : args.lam_init3);
            } else if (k == 3) {
                pg8::Gemm g{XB, wl + (L < 2 ? CW_W13 : AW_W13), M, NFF2, D}; pg8::StaticOrder S; S.init(M, NFF2, F.G, (int)blockIdx.x);
                pg8::EpiGate<1> E{(bf16*)(ws + WS_H), FF, SSQ, nullptr};
                pg8::gemm_phase<pg8::EpiGate<1>, pg8::StaticOrder, true, true>(F.lds + RING_OFF, g, S, E);
            } else {
                const bf16* Aop; const bf16* Bop; int K; const float* bias = nullptr; const float* base = X;
                if (k == 4) { Aop = (const bf16*)(ws + WS_H); Bop = wl + (L < 2 ? CW_W2 : AW_W2); K = FF; }
                else if (L < 2) { Aop = (const bf16*)(ws + WS_U); Bop = wl + CW_PW2; K = D; bias = args.in[9] + L * D; if (L == 0) base = args.in[0]; }
                else { Aop = (const bf16*)(ws + WS_QO); Bop = wl + AW_WO; K = D; }
                pg8::Gemm g{Aop, Bop, M, D, K}; pg8::StaticOrder S; S.init(M, D, F.G, (int)blockIdx.x);
                pg8::EpiRes E{base, X, XB, SSQ, bias};
                if (F.G == 256) pg8::gemm_phase<pg8::EpiRes, pg8::StaticOrder, false, true>(F.lds + RING_OFF, g, S, E);
            }
        }
#if PROBE_REP
      }
      if ((PROBE_REP >> 6) & 1) { if (ph + 1 < hi) xcd_barrier(bar); }
#endif
        if (ph + 1 < hi) xcd_barrier(bar);
    }
}

#ifndef MK_ONE_LAUNCH
#define MK_ONE_LAUNCH 0
#endif
extern "C" void kernel_launch(void* const* d_in, const int* in_sizes, int n_in, void* d_out, int out_size, void* d_ws, size_t ws_size, hipStream_t stream) {
    static int grid = 0;
    if (grid == 0) {
        if (n_in != 26 || in_sizes[0] != M * D || out_size != M * D || ws_size < WS_END) { fprintf(stderr, "kernel_launch: unexpected shapes (n_in %d, in0 %d, out %d, ws %zu); nothing launched\n", n_in, n_in > 0 ? in_sizes[0] : -1, out_size, ws_size); grid = -1; return; }
        int dev = 0, cus = 0, per_cu = 0;
        if (hipGetDevice(&dev) != hipSuccess || hipDeviceGetAttribute(&cus, hipDeviceAttributeMultiprocessorCount, dev) != hipSuccess) { grid = -1; return; }
        if (hipFuncSetAttribute((const void*)yoco_fwd, hipFuncAttributeMaxDynamicSharedMemorySize, LDS_BYTES) != hipSuccess) { fprintf(stderr, "kernel_launch: hipFuncSetAttribute failed\n"); grid = -1; return; }
        if (hipOccupancyMaxActiveBlocksPerMultiprocessor(&per_cu, (const void*)yoco_fwd, NWAVES * 64, LDS_BYTES) != hipSuccess || per_cu < 1) { fprintf(stderr, "kernel_launch: occupancy query says %d blocks per CU\n", per_cu); }
        (void)hipGetLastError();
        grid = cus;
        if (grid != 256) fprintf(stderr, "kernel_launch: %d CUs; the residual GEMM phases need exactly 256 workgroups\n", grid);
    }
    if (grid < 0) return;
    if (hipMemsetAsync((char*)d_ws + WS_CTL, 0, CTL_ZERO_BYTES, stream) != hipSuccess) return;
    Args a{};
    for (int i = 0; i < 26; ++i) a.in[i] = (const float*)d_in[i];
    a.out = (float*)d_out; a.ws = (unsigned char*)d_ws;
    a.lam_init2 = (float)(0.8 - 0.6 * exp(-0.3 * 2.0)); a.lam_init3 = (float)(0.8 - 0.6 * exp(-0.3 * 3.0));
#if MK_ONE_LAUNCH
    a.ph_lo = 0; a.ph_hi = N_PHASES;
    hipLaunchKernelGGL(yoco_fwd, dim3(grid), dim3(NWAVES * 64), LDS_BYTES, stream, a);
#else
    for (int p = 0; p < N_PHASES; ++p) { a.ph_lo = p; a.ph_hi = p + 1; hipLaunchKernelGGL(yoco_fwd, dim3(grid), dim3(NWAVES * 64), LDS_BYTES, stream, a); }
#endif
}
```

```cpp
#define MK_ONE_LAUNCH 1
#define PROBE_REP 0
#include <hip/hip_runtime.h>
#include <cstdio>
#include <cstdint>
#include <cmath>
namespace pg8 {
#define PG8_LAS __attribute__((address_space(3)))
typedef unsigned short bf16_t;
typedef short bf16x8 __attribute__((ext_vector_type(8)));
typedef float f32x4 __attribute__((ext_vector_type(4)));
typedef unsigned u32x4 __attribute__((ext_vector_type(4)));
constexpr int BM = 256, BK = 64, HALF = 128, HTB = HALF * BK * 2  , STAGE_BYTES = 8 * HTB, NXCD = 8, WGM = 8;

__host__ __device__ __forceinline__ int lds_byte(int r, int c) { const int st = (r >> 4) * 2 + (c >> 5), rr = r & 15, cc = c & 31, ob = rr * 64 + cc * 2; return st * 1024 + (ob ^ (((ob >> 9) & 1) << 5)); }
__host__ __device__ __forceinline__ void stage_rc(int b, int& R, int& C) { const int st = b / 1024, sb = b % 1024, swz = sb ^ (((sb >> 9) & 1) << 5); R = (st >> 1) * 16 + swz / 64; C = (st & 1) * 32 + (swz % 64) / 2; }
__host__ __device__ __forceinline__ int perm32(int rho) { const int n = rho >> 4, i = rho & 15; return 8 * (i >> 2) + 4 * n + (i & 3); }

struct Unit { int pm, pn; };
struct Gemm { const bf16_t* A; const bf16_t* Bt; int M, N, K; };

struct StaticOrder {
    int nM, nN, nwg, G, c;
    __host__ __device__ void init(int M, int N, int G_, int c_) { nM = M / BM; nN = N / BM; nwg = nM * nN; G = G_; c = c_; }
    __host__ __device__ bool next(int i, Unit& u) const {
        const long L = (long)i * G + c; if (L >= nwg) return false;
        int wgid = (int)L; { const int q = nwg / NXCD, r = nwg % NXCD, xcd = wgid % NXCD, off = wgid / NXCD; wgid = (xcd < r ? xcd * (q + 1) : r * (q + 1) + (xcd - r) * q) + off; }
        const int nig = WGM * nN, gid = wgid / nig, fm = gid * WGM, gsz = (nM - fm) < WGM ? (nM - fm) : WGM;
        u.pm = fm + ((wgid % nig) % gsz); u.pn = (wgid % nig) / gsz; return true;
    }
    __device__ __forceinline__ void a_ready(const Unit&) const {}
    __device__ __forceinline__ void done(const Unit&) const {}
};

__device__ __forceinline__ unsigned cvt_pk_bf16(float lo, float hi) { unsigned r; asm volatile("v_cvt_pk_bf16_f32 %0, %1, %2" : "=v"(r) : "v"(lo), "v"(hi)); return r; }
typedef unsigned u32x2 __attribute__((ext_vector_type(2)));
constexpr float NORM_EPS = 1e-6f;
__device__ __forceinline__ float row_rstd(const float* ssq, int row) { const f32x4 s = *(const f32x4*)(ssq + (size_t)row * 4); return __builtin_amdgcn_rsqf(((s[0] + s[1]) + (s[2] + s[3])) * (1.0f / 1024.0f) + NORM_EPS); }
__device__ __forceinline__ float sigmoidf_(float x) { return __builtin_amdgcn_rcpf(1.0f + __builtin_amdgcn_exp2f(-1.4426950408889634f * x)); }

template <int MODE> struct EpiGate {
    static constexpr bool PERM = true, AFTER_DRAIN = false;
    bf16_t* O; int ldc; const float* ssq; const float* bias;
    __device__ __forceinline__ void operator()(const f32x4 (&acc)[2][2][4][2], const Unit& u, int wr, int wc, int fr, int fq) const {
        const int row0 = u.pm * BM + wr * 64 + fr, ch0 = u.pn * HALF + wc * 32 + 8 * fq;
        f32x4 ba[2], bg[2];
#pragma unroll
        for (int n = 0; n < 2; ++n) {
            if (MODE == 0) { ba[n] = *(const f32x4*)(bias + ch0 + 4 * n); bg[n] = *(const f32x4*)(bias + 1024 + ch0 + 4 * n); }
            else { ba[n] = (f32x4){0.f, 0.f, 0.f, 0.f}; bg[n] = (f32x4){0.f, 0.f, 0.f, 0.f}; } }
        float rsv[2][4];
#pragma unroll
        for (int ai = 0; ai < 2; ++ai)
#pragma unroll
            for (int m = 0; m < 4; ++m) rsv[ai][m] = row_rstd(ssq, row0 + ai * HALF + m * 16);
        asm volatile("" ::: "memory");
#pragma unroll
        for (int ai = 0; ai < 2; ++ai)
#pragma unroll
            for (int m = 0; m < 4; ++m) { const int row = row0 + ai * HALF + m * 16; const float rs = rsv[ai][m];
                u32x4 w;
#pragma unroll
                for (int n = 0; n < 2; ++n) { const f32x4 a = acc[ai][0][m][n] * rs + ba[n], g = acc[ai][1][m][n] * rs + bg[n]; f32x4 y;
#pragma unroll
                    for (int i = 0; i < 4; ++i) y[i] = (MODE == 0) ? a[i] * sigmoidf_(g[i]) : (a[i] * sigmoidf_(a[i])) * g[i];
                    w[2 * n] = cvt_pk_bf16(y[0], y[1]); w[2 * n + 1] = cvt_pk_bf16(y[2], y[3]); }
                *(u32x4*)(O + (size_t)row * ldc + ch0) = w; asm volatile("" ::: "memory"); }
    }
};
template <size_t OFFQ, size_t OFFK, size_t OFFV> struct EpiQKV {
    static constexpr bool PERM = true, AFTER_DRAIN = false;
    unsigned char* ws; const float* ssq; float qscale;
    __device__ __forceinline__ void operator()(const f32x4 (&acc)[2][2][4][2], const Unit& u, int wr, int wc, int fr, int fq) const {
        const int row0 = u.pm * BM + wr * 64 + fr; int colt = u.pn * BM; const int t = colt >> 10; colt &= 1023;
        const size_t boff = (t == 0 ? OFFQ : 0) + (t == 1 ? OFFK : 0) + (t == 2 ? OFFV : 0);
        bf16_t* base = (bf16_t*)(ws + boff); const float sc = (t == 0) ? qscale : 1.0f;
        const int col0 = colt + wc * 32 + 8 * fq;
        float rsv[2][4];
#pragma unroll
        for (int ai = 0; ai < 2; ++ai)
#pragma unroll
            for (int m = 0; m < 4; ++m) rsv[ai][m] = row_rstd(ssq, row0 + ai * HALF + m * 16) * sc;
        asm volatile("" ::: "memory");
#pragma unroll
        for (int ai = 0; ai < 2; ++ai)
#pragma unroll
            for (int m = 0; m < 4; ++m) { const int row = row0 + ai * HALF + m * 16; const float rs = rsv[ai][m]; bf16_t* rowp = base + (size_t)row * 1024 + col0;
#pragma unroll
                for (int bj = 0; bj < 2; ++bj) { const f32x4 v0 = acc[ai][bj][m][0] * rs, v1 = acc[ai][bj][m][1] * rs; u32x4 w;
                    w.x = cvt_pk_bf16(v0[0], v0[1]); w.y = cvt_pk_bf16(v0[2], v0[3]); w.z = cvt_pk_bf16(v1[0], v1[1]); w.w = cvt_pk_bf16(v1[2], v1[3]);
                    *(u32x4*)(rowp + bj * HALF) = w; } asm volatile("" ::: "memory"); }
    }
};
struct EpiRes {
    static constexpr bool PERM = false, AFTER_DRAIN = true;
    const float* base; float* out; bf16_t* xb; float* ssq; const float* bias;
    __device__ __forceinline__ void fused(f32x4 (&acc)[2][2][4][2], const Unit& u, int wr, int wc, int fr, int fq, PG8_LAS unsigned char* lds, int wid, int lane) const {
        const int col0 = u.pn * BM + wc * 32 + 4 * fq;
        PG8_LAS float* P = (PG8_LAS float*)lds;
        f32x4 bv[2][2];
#pragma unroll
        for (int bj = 0; bj < 2; ++bj)
#pragma unroll
            for (int n = 0; n < 2; ++n) bv[bj][n] = bias ? *(const f32x4*)(bias + col0 + bj * HALF + n * 16) : (f32x4){0.f, 0.f, 0.f, 0.f};
#pragma unroll
        for (int ai = 0; ai < 2; ++ai)
#pragma unroll
            for (int m = 0; m < 4; ++m) { const int r = ai * HALF + wr * 64 + m * 16 + fr; const size_t off = (size_t)(u.pm * BM + r) * 1024 + col0; float ss = 0.f;
#pragma unroll
                for (int bj = 0; bj < 2; ++bj)
#pragma unroll
                    for (int n = 0; n < 2; ++n) { const size_t c = off + bj * HALF + n * 16; const f32x4 bs = *(const f32x4*)(base + c); const f32x4 o = bs + acc[ai][bj][m][n] + bv[bj][n];
                        *(f32x4*)(out + c) = o; u32x2 w; w.x = cvt_pk_bf16(o[0], o[1]); w.y = cvt_pk_bf16(o[2], o[3]); *(u32x2*)(xb + c) = w;
                        ss += (o[0] * o[0] + o[1] * o[1]) + (o[2] * o[2] + o[3] * o[3]); }
                ss += __int_as_float(__builtin_amdgcn_ds_swizzle(__float_as_int(ss), (16 << 10) | 0x1f));
                { auto rr = __builtin_amdgcn_permlane32_swap(__float_as_uint(ss), __float_as_uint(ss), false, false); ss = __uint_as_float(rr[0]) + __uint_as_float(rr[1]); }
                if (fq == 0) P[r * 4 + wc] = ss;
                if (m & 1) asm volatile("" ::: "memory"); }
        asm volatile("s_waitcnt lgkmcnt(0)" ::: "memory"); __builtin_amdgcn_s_barrier(); asm volatile("" ::: "memory");
        const int tid = wid * 64 + lane;
        if (tid < 256) { const PG8_LAS f32x4* P4 = (const PG8_LAS f32x4*)lds; const f32x4 p = P4[tid]; ssq[(size_t)(u.pm * BM + tid) * 4 + u.pn] = (p[0] + p[1]) + (p[2] + p[3]); }
    }
};

template <class Epi, class Sched, bool ALIGN_EPI = false, bool SP2 = false>
__device__ __forceinline__ void gemm_phase(PG8_LAS unsigned char* lds, const Gemm g, const Sched& S, const Epi& E, const int wave_id) {
    unsigned msk_ = ~0u; asm volatile("" : "+s"(msk_)); int tid_ = (int)__builtin_amdgcn_mbcnt_hi(msk_, __builtin_amdgcn_mbcnt_lo(msk_, 0u)); asm volatile("" : "+v"(tid_)); tid_ |= wave_id << 6;
    const int tid = tid_, wid = __builtin_amdgcn_readfirstlane(tid >> 6), lane = tid & 63, wr = wid >> 2, wc = wid & 3, fr = lane & 15, fq = lane >> 4;
    const int K = g.K, nt = K / BK;
    unsigned voffA[2], voffB[2];
#pragma unroll
    for (int i = 0; i < 2; ++i) { int R, C; stage_rc(tid * 16 + i * 8192, R, C); const int Rb = Epi::PERM ? ((R & ~31) + perm32(R & 31)) : R;
        voffA[i] = (unsigned)(R * K + C) * 2u; voffB[i] = (unsigned)(Rb * K + C) * 2u; }
    const size_t kstep = (size_t)(BK * 2);
    const size_t hstep = (size_t)HALF * K * 2;
    const size_t tstep = 2 * hstep;
    const unsigned ldsw = (unsigned)wid * 1024u;
    const int aoff = lds_byte(wr * 64 + fr, fq * 8), boff = lds_byte(wc * 32 + fr, fq * 8);
#define PG8_SA(b, h) (((b) * 2 + (h)) * HTB)
#define PG8_SB(b, h) ((4 + (b) * 2 + (h)) * HTB)
#define PG8_STAGE(bufoff, gbase, voff) do { _Pragma("unroll") for (int _i = 0; _i < 2; ++_i) \
        __builtin_amdgcn_global_load_lds((const unsigned*)((const char*)(gbase) + (voff)[_i]), (PG8_LAS unsigned*)(lds + (bufoff) + ldsw + _i * 8192), 16, 0, 0); } while (0)
#define PG8_LDA(dst, b, h) do { _Pragma("unroll") for (int m = 0; m < 4; ++m) _Pragma("unroll") for (int k = 0; k < 2; ++k) dst[m][k] = *(const PG8_LAS bf16x8*)(lds + PG8_SA(b, h) + aoff + m * 2048 + k * 1024); } while (0)
#define PG8_LDB(dst, b, h) do { _Pragma("unroll") for (int n = 0; n < 2; ++n) _Pragma("unroll") for (int k = 0; k < 2; ++k) dst[n][k] = *(const PG8_LAS bf16x8*)(lds + PG8_SB(b, h) + boff + n * 2048 + k * 1024); } while (0)
#define PG8_MMA(ai, bj, At, Bt) do { __builtin_amdgcn_s_setprio(1); _Pragma("unroll") for (int m = 0; m < 4; ++m) _Pragma("unroll") for (int n = 0; n < 2; ++n) _Pragma("unroll") for (int k = 0; k < 2; ++k) \
        acc[ai][bj][m][n] = __builtin_amdgcn_mfma_f32_16x16x32_bf16(Bt[n][k], At[m][k], acc[ai][bj][m][n], 0, 0, 0); __builtin_amdgcn_s_setprio(0); } while (0)
#define PG8_WAIT_V(n) asm volatile("s_waitcnt vmcnt(" #n ")" ::: "memory")
#define PG8_WAIT_L(n) asm volatile("s_waitcnt lgkmcnt(" #n ")" ::: "memory")
#define PG8_BAR __builtin_amdgcn_s_barrier()
#define PG8_SCHED __builtin_amdgcn_sched_barrier(0)
    Unit cur, nxt; int ui = 0;
    if (!S.next(0, cur)) return;
    f32x4 acc[2][2][4][2];
#pragma unroll
    for (int a = 0; a < 2; ++a)
#pragma unroll
        for (int b = 0; b < 2; ++b)
#pragma unroll
            for (int m = 0; m < 4; ++m)
#pragma unroll
                for (int n = 0; n < 2; ++n) acc[a][b][m][n] = (f32x4){0.f, 0.f, 0.f, 0.f};
    bf16x8 At[4][2], B0[2][2], B1[2][2];
    const char* cA = (const char*)g.A + (size_t)cur.pm * tstep; const char* cB = (const char*)g.Bt + (size_t)cur.pn * tstep;
    S.a_ready(cur);
    if constexpr (SP2) {
        PG8_STAGE(PG8_SB(0, 0), cB, voffB); PG8_STAGE(PG8_SB(0, 1), cB + hstep, voffB); PG8_STAGE(PG8_SA(0, 0), cA, voffA); PG8_STAGE(PG8_SA(0, 1), cA + hstep, voffA);
        if (wr == 1) PG8_BAR;
        PG8_WAIT_V(2); PG8_BAR;
        PG8_STAGE(PG8_SB(1, 0), cB + kstep, voffB); PG8_STAGE(PG8_SA(1, 0), cA + kstep, voffA); PG8_STAGE(PG8_SB(1, 1), cB + hstep + kstep, voffB);
        PG8_WAIT_V(6); PG8_BAR;
    } else {
        PG8_STAGE(PG8_SB(0, 0), cB, voffB); PG8_STAGE(PG8_SA(0, 0), cA, voffA); PG8_STAGE(PG8_SB(0, 1), cB + hstep, voffB); PG8_STAGE(PG8_SA(0, 1), cA + hstep, voffA);
        if (wr == 1) PG8_BAR;
        PG8_WAIT_V(4); PG8_BAR;
        PG8_STAGE(PG8_SB(1, 0), cB + kstep, voffB); PG8_STAGE(PG8_SA(1, 0), cA + kstep, voffA); PG8_STAGE(PG8_SB(1, 1), cB + hstep + kstep, voffB);
        PG8_WAIT_V(6); PG8_BAR;
    }
    for (;;) {
        const bool has_next = S.next(ui + 1, nxt);
        const char* nA = has_next ? (const char*)g.A + (size_t)nxt.pm * tstep : cA; const char* nB = has_next ? (const char*)g.Bt + (size_t)nxt.pn * tstep : cB;
        for (int t = 0; t < nt; t += 2) {
            const bool last = (t == nt - 2);
            const char* a1 = cA + (size_t)(t + 1) * kstep;
            const char* a2 = last ? nA : cA + (size_t)(t + 2) * kstep; const char* b2 = last ? nB : cB + (size_t)(t + 2) * kstep;
            const char* a3 = a2 + kstep; const char* b3 = b2 + kstep;
            if (last && has_next) S.a_ready(nxt);
            if constexpr (SP2) {
            PG8_LDB(B0, 0, 0); PG8_LDB(B1, 0, 1); PG8_SCHED; PG8_LDA(At, 0, 0); PG8_STAGE(PG8_SA(1, 1), a1 + hstep, voffA);
            PG8_WAIT_V(8); PG8_WAIT_L(0); PG8_BAR; PG8_MMA(0, 0, At, B0); PG8_MMA(0, 1, At, B1); PG8_BAR; PG8_SCHED;
            PG8_LDA(At, 0, 1); PG8_STAGE(PG8_SB(0, 0), b2, voffB); PG8_STAGE(PG8_SB(0, 1), b2 + hstep, voffB); PG8_STAGE(PG8_SA(0, 0), a2, voffA);
            PG8_WAIT_V(8); PG8_WAIT_L(0); PG8_BAR; PG8_MMA(1, 0, At, B0); PG8_MMA(1, 1, At, B1); PG8_BAR; PG8_SCHED;
            PG8_LDB(B0, 1, 0); PG8_LDB(B1, 1, 1); PG8_SCHED; PG8_LDA(At, 1, 0); PG8_STAGE(PG8_SA(0, 1), a2 + hstep, voffA);
            PG8_WAIT_V(8); PG8_WAIT_L(0); PG8_BAR; PG8_MMA(0, 0, At, B0); PG8_MMA(0, 1, At, B1); PG8_BAR; PG8_SCHED;
            PG8_LDA(At, 1, 1); PG8_STAGE(PG8_SB(1, 0), b3, voffB); PG8_STAGE(PG8_SB(1, 1), b3 + hstep, voffB); PG8_STAGE(PG8_SA(1, 0), a3, voffA);
            PG8_WAIT_V(8); PG8_WAIT_L(0); PG8_BAR; PG8_MMA(1, 0, At, B0); PG8_MMA(1, 1, At, B1); PG8_BAR; PG8_SCHED;
            } else {
            PG8_LDB(B0, 0, 0); PG8_SCHED; PG8_LDA(At, 0, 0); PG8_STAGE(PG8_SA(1, 1), a1 + hstep, voffA);
            PG8_WAIT_L(8); PG8_BAR; PG8_WAIT_L(0); PG8_MMA(0, 0, At, B0); PG8_BAR; PG8_SCHED;
            PG8_LDB(B1, 0, 1); PG8_STAGE(PG8_SB(0, 0), b2, voffB);
            PG8_BAR; PG8_WAIT_L(0); PG8_MMA(0, 1, At, B1); PG8_BAR;
            PG8_LDA(At, 0, 1); PG8_STAGE(PG8_SA(0, 0), a2, voffA);
            PG8_BAR; PG8_WAIT_L(0); PG8_MMA(1, 0, At, B0); PG8_BAR; PG8_SCHED;
            PG8_STAGE(PG8_SB(0, 1), b2 + hstep, voffB);
            PG8_WAIT_V(6); PG8_BAR; PG8_MMA(1, 1, At, B1); PG8_BAR;
            PG8_LDB(B0, 1, 0); PG8_SCHED; PG8_LDA(At, 1, 0); PG8_STAGE(PG8_SA(0, 1), a2 + hstep, voffA);
            PG8_WAIT_L(8); PG8_BAR; PG8_WAIT_L(0); PG8_MMA(0, 0, At, B0); PG8_BAR; PG8_SCHED;
            PG8_LDB(B1, 1, 1); PG8_STAGE(PG8_SB(1, 0), b3, voffB);
            PG8_BAR; PG8_WAIT_L(0); PG8_MMA(0, 1, At, B1); PG8_BAR;
            PG8_LDA(At, 1, 1); PG8_STAGE(PG8_SA(1, 0), a3, voffA);
            PG8_BAR; PG8_WAIT_L(0); PG8_MMA(1, 0, At, B0); PG8_BAR; PG8_SCHED;
            PG8_STAGE(PG8_SB(1, 1), b3 + hstep, voffB);
            PG8_WAIT_V(6); PG8_BAR; PG8_MMA(1, 1, At, B1); PG8_BAR;
            }
        }
        if constexpr (ALIGN_EPI) { if (wr == 0) PG8_BAR; }
        if constexpr (!Epi::AFTER_DRAIN) { E(acc, cur, wr, wc, fr, fq); S.done(cur); }
        if (!has_next) break;
#pragma unroll
        for (int a = 0; a < 2; ++a)
#pragma unroll
            for (int b = 0; b < 2; ++b)
#pragma unroll
                for (int m = 0; m < 4; ++m)
#pragma unroll
                    for (int n = 0; n < 2; ++n) acc[a][b][m][n] = (f32x4){0.f, 0.f, 0.f, 0.f};
        cur = nxt; cA = nA; cB = nB; ++ui;
        if constexpr (ALIGN_EPI) { if (wr == 1) PG8_BAR; }
    }
    PG8_WAIT_V(0);
    if constexpr (!ALIGN_EPI) { if (wr == 0) PG8_BAR; }
    PG8_BAR;
    if constexpr (Epi::AFTER_DRAIN) { E.fused(acc, cur, wr, wc, fr, fq, lds, wid, lane); S.done(cur); }
#undef PG8_SA
#undef PG8_SB
#undef PG8_STAGE
#undef PG8_LDA
#undef PG8_LDB
#undef PG8_MMA
#undef PG8_WAIT_V
#undef PG8_WAIT_L
#undef PG8_BAR
#undef PG8_SCHED
}
}
#define GAS __attribute__((address_space(1)))
#define LAS __attribute__((address_space(3)))
typedef unsigned short bf16;
typedef unsigned v4u __attribute__((ext_vector_type(4)));
typedef float f32x4 __attribute__((ext_vector_type(4)));
typedef short bf16x8 __attribute__((ext_vector_type(8)));
typedef GAS unsigned gu32;
typedef GAS unsigned long long gu64;
#define RLX_AGENT __ATOMIC_RELAXED, __HIP_MEMORY_SCOPE_AGENT
#define LDS_WAIT() asm volatile("s_waitcnt lgkmcnt(0)" ::: "memory")
#define VM_WAIT() asm volatile("s_waitcnt vmcnt(0)" ::: "memory")
__device__ __forceinline__ unsigned long long rt() { return __builtin_amdgcn_s_memrealtime(); }
__device__ __forceinline__ unsigned f2bf(float f) { unsigned u = __builtin_bit_cast(unsigned, f); return (u + 0x7fffu + ((u >> 16) & 1u)) >> 16; }
__device__ __forceinline__ unsigned pk2(float lo, float hi) { return f2bf(lo) | (f2bf(hi) << 16); }

#define XB_TMO      128
#define XB_XCNT(j)  (256  + 64 * (j))
#define XB_XSUB(j)  (1280 + 64 * (j))
#define XB_XGEN(j)  (2304 + 64 * (j))
#define XB_TOP      3328
#define XB_TOPGEN   3392
#define XCD_BAR_WORDS 3456
#define XB_SPIN_CAP (1u << 18)

__device__ __forceinline__ unsigned xb_ld(unsigned* p)              { return __hip_atomic_load(p, __ATOMIC_RELAXED, __HIP_MEMORY_SCOPE_AGENT); }
__device__ __forceinline__ unsigned xb_add(unsigned* p, unsigned v) { return __hip_atomic_fetch_add(p, v, __ATOMIC_RELAXED, __HIP_MEMORY_SCOPE_AGENT); }
__device__ __forceinline__ unsigned xb_xcc_id() { return (unsigned)__builtin_amdgcn_s_getreg((3 << 11) | 20) & 0xFu; }
#define XB_SPIN(cond, bar) do { unsigned _sp = 0; while (cond) { __builtin_amdgcn_s_sleep(1); \
    if ((++_sp & 255u) == 0u) { if (xb_ld(&(bar)[XB_TMO])) break; if (_sp > XB_SPIN_CAP) { atomicAdd(&(bar)[XB_TMO], 1u); break; } } } } while (0)

struct XcdBarrier {
    unsigned* bar; unsigned x;
    volatile LAS unsigned* st;
};

__device__ __forceinline__ XcdBarrier xcd_barrier_post(unsigned* bar, volatile LAS unsigned* st, const bool leader  ) {
    XcdBarrier b; b.bar = bar; b.x = xb_xcc_id(); b.st = st;
    if (leader) (void)xb_add(&bar[XB_XCNT(b.x)], 1u);
    return b;
}
__device__ __forceinline__ void xcd_barrier_complete(unsigned* bar, unsigned x, unsigned& nloc, unsigned& nx) {
    const unsigned G = gridDim.x * gridDim.y * gridDim.z;
    unsigned sum, cnt, mine, sp = 0u;
    for (;;) {
        sum = 0u; cnt = 0u; mine = 0u;
#pragma unroll
        for (unsigned j = 0; j < 16; ++j) { const unsigned c = xb_ld(&bar[XB_XCNT(j)]); sum += c; cnt += (c > 0u) ? 1u : 0u; mine = (j == x) ? c : mine; }
        if (sum == G) break;
        __builtin_amdgcn_s_sleep(1);
        if ((++sp & 255u) == 0u) { if (xb_ld(&bar[XB_TMO])) break; if (sp > XB_SPIN_CAP) { atomicAdd(&bar[XB_TMO], 1u); break; } }
    }
    nloc = mine > 0u ? mine : 1u; nx = cnt > 0u ? cnt : 1u;
}

__device__ __forceinline__ void xcd_barrier(const XcdBarrier& b, const bool leader  ) {
    asm volatile("s_waitcnt vmcnt(0)" ::: "memory");
    __syncthreads();
    if (leader) {
        unsigned* bar = b.bar;
        __builtin_amdgcn_s_waitcnt(0);
        unsigned nloc = b.st[0], nx = b.st[1];
        if (nloc == 0u) { xcd_barrier_complete(bar, b.x, nloc, nx); b.st[0] = nloc; b.st[1] = nx; }
        const unsigned old = xb_add(&bar[XB_XSUB(b.x)], 1u);
        const unsigned gen = old / nloc;
        if (old + 1u == (gen + 1u) * nloc) {
            __builtin_amdgcn_fence(__ATOMIC_RELEASE, "agent");
            asm volatile("s_waitcnt vmcnt(0)" ::: "memory");
            const unsigned og = xb_add(&bar[XB_TOP], 1u);
            const unsigned tg = og / nx;
            if (og + 1u == (tg + 1u) * nx) xb_add(&bar[XB_TOPGEN], 1u);
            else XB_SPIN(xb_ld(&bar[XB_TOPGEN]) == tg, bar);
            __builtin_amdgcn_fence(__ATOMIC_ACQUIRE, "agent");
            xb_add(&bar[XB_XGEN(b.x)], 1u);
            asm volatile("s_waitcnt vmcnt(0)" ::: "memory");
        } else {
            XB_SPIN(xb_ld(&bar[XB_XGEN(b.x)]) == gen, bar);
            __builtin_amdgcn_fence(__ATOMIC_ACQUIRE, "agent");
            asm volatile("s_waitcnt vmcnt(0)" ::: "memory");
        }
    }
    __syncthreads();
}

constexpr int NWAVES = 8;
constexpr int NB = 8, SEQ = 2048, D = 1024, M = NB * SEQ, FF = 2816, NFF2 = 2 * FF, NH = 8, CW = 31;
constexpr float EPS = 1e-6f;
constexpr float LOG2E = 1.4426950408889634f;
constexpr float QSCALE = 0.125f * LOG2E;
constexpr int N_PHASES = 22;

constexpr size_t MiB = 1u << 20;
constexpr size_t WS_CTL = 0, CTL_ZERO_BYTES = 64 * 1024;
constexpr size_t WS_SSQ = 1 * MiB;
constexpr size_t CONF_W_ELEMS = (size_t)2048 * 1024 + (size_t)1024 * 1024 + (size_t)5632 * 1024 + (size_t)1024 * 2816;
constexpr size_t ATT_W_ELEMS  = (size_t)3072 * 1024 + (size_t)1024 * 1024 + (size_t)5632 * 1024 + (size_t)1024 * 2816;
constexpr size_t CW_PW1 = 0, CW_PW2 = (size_t)2048 * 1024, CW_W13 = CW_PW2 + (size_t)1024 * 1024, CW_W2 = CW_W13 + (size_t)5632 * 1024;
constexpr size_t AW_QKV = 0, AW_WO = (size_t)3072 * 1024, AW_W13 = AW_WO + (size_t)1024 * 1024, AW_W2 = AW_W13 + (size_t)5632 * 1024;
constexpr size_t WS_WC = 2 * MiB;
constexpr size_t WS_WA = WS_WC + 2 * CONF_W_ELEMS * 2;
constexpr size_t WS_XB = WS_WA + 2 * ATT_W_ELEMS * 2;
constexpr size_t WS_V  = WS_XB + 32 * MiB;
constexpr size_t WS_R  = WS_V + 32 * MiB;
constexpr size_t WS_K  = WS_WC;
constexpr size_t WS_H = WS_R, WS_G = WS_R, WS_U = WS_R + 32 * MiB, WS_QO = WS_R, WS_O0 = WS_R + 32 * MiB;
constexpr size_t WS_END = WS_R + 96 * MiB;
static_assert(WS_WA == 47 * MiB && WS_XB == 96 * MiB && WS_R == 160 * MiB && WS_END == 256 * MiB, "d_ws map");
static_assert((size_t)M * FF * 2 <= 96 * MiB && WS_K + 32 * MiB <= WS_WA, "d_ws overlays");

constexpr int RING_OFF = 0, RING_BYTES = 131072;
constexpr int LDSCTL_OFF = RING_BYTES, MISC_OFF = LDSCTL_OFF + 320;
constexpr int LDS_BYTES = 147456;

typedef float f32x16 __attribute__((ext_vector_type(16)));
typedef short s16x4 __attribute__((ext_vector_type(4)));
typedef float f32x2 __attribute__((ext_vector_type(2)));
typedef unsigned u32x2 __attribute__((ext_vector_type(2)));
typedef unsigned u32x4 __attribute__((ext_vector_type(4)));

struct Args { const float* in[26]; float* out; unsigned char* ws; int ph_lo, ph_hi; float lam_init2, lam_init3; };
struct Frame {
    LAS unsigned char* lds; volatile LAS unsigned* MISC; gu32* ctl;
    int tid, lane, wave, vcu, G;
};
template <int MSK> __device__ __forceinline__ float shx(float v) { return __int_as_float(__builtin_amdgcn_ds_swizzle(__float_as_int(v), (MSK << 10) | 0x1f)); }
__device__ __forceinline__ float half_sum(float v) { auto rr = __builtin_amdgcn_permlane32_swap(__float_as_uint(v), __float_as_uint(v), false, false); return __uint_as_float(rr[0]) + __uint_as_float(rr[1]); }
__device__ __forceinline__ float half_max(float v) { auto rr = __builtin_amdgcn_permlane32_swap(__float_as_uint(v), __float_as_uint(v), false, false); return fmaxf(__uint_as_float(rr[0]), __uint_as_float(rr[1])); }
__device__ __forceinline__ float half_other(float v, bool up) { auto rr = __builtin_amdgcn_permlane32_swap(__float_as_uint(v), __float_as_uint(v), false, false); return __uint_as_float(up ? rr[0] : rr[1]); }
__device__ __forceinline__ float wave_sum(float v) {
    v += shx<1>(v); v += shx<2>(v); v += shx<4>(v); v += shx<8>(v); v += shx<16>(v); return half_sum(v);
}
template <int O, int N> __device__ __forceinline__ void bfly_round(float (&v)[64], int lane) {
    const bool up = (lane & O) != 0;
#pragma unroll
    for (int i = 0; i < N; ++i) { const float send = up ? v[i] : v[i + N]; const float keep = up ? v[i + N] : v[i]; const float got = (O == 32) ? half_other(send, up) : shx<(O == 32 ? 1 : O)>(send); v[i] = keep + got; }
}
__device__ __forceinline__ int fresh_lane() { unsigned m = ~0u; asm volatile("" : "+s"(m)); int l = (int)__builtin_amdgcn_mbcnt_hi(m, __builtin_amdgcn_mbcnt_lo(m, 0u)); asm volatile("" : "+v"(l)); return l; }
__device__ __forceinline__ void refresh(Frame& F) { F.lane = fresh_lane(); F.tid = (F.wave << 6) | F.lane; }
__device__ __forceinline__ float bf_lo(unsigned v) { return __uint_as_float(v << 16); }
__device__ __forceinline__ float bf_hi(unsigned v) { return __uint_as_float(v & 0xffff0000u); }

__device__ __forceinline__ void p0_transpose_item(const float* W, int ld, int K, int nblk, const float* gain, bf16* WT, int ilv, int row_off, LAS float* scr, int item, int lane) {
    const int kb = item / nblk, nb = item % nblk, k0 = 64 * kb, n0 = 32 * nb;
    const GAS float* src = (const GAS float*)W + (size_t)(k0 + (lane >> 5)) * ld + n0 + (lane & 31);
    float v[32];
#pragma unroll
    for (int i = 0; i < 32; ++i) v[i] = src[(size_t)(2 * i) * ld];
    const int c = lane & 7;
    f32x4 g0 = (f32x4){1.f, 1.f, 1.f, 1.f}, g1 = g0;
    if (gain) { g0 = *(const GAS f32x4*)(gain + k0 + 8 * c); g1 = *(const GAS f32x4*)(gain + k0 + 8 * c + 4); }
#pragma unroll
    for (int i = 0; i < 32; ++i) scr[(2 * i + (lane >> 5)) * 33 + (lane & 31)] = v[i];
    LDS_WAIT(); asm volatile("" ::: "memory");
    const int d0 = (ilv ? (((n0 >> 7) << 8) + (n0 & 127)) : n0) + row_off;
#pragma unroll
    for (int j = 0; j < 4; ++j) { const int n = (lane >> 3) + 8 * j; const LAS float* s = scr + (8 * c) * 33 + n;
        v4u o; o.x = pk2(s[0 * 33] * g0[0], s[1 * 33] * g0[1]); o.y = pk2(s[2 * 33] * g0[2], s[3 * 33] * g0[3]); o.z = pk2(s[4 * 33] * g1[0], s[5 * 33] * g1[1]); o.w = pk2(s[6 * 33] * g1[2], s[7 * 33] * g1[3]);
        *(GAS v4u*)(WT + (size_t)(d0 + n) * K + k0 + 8 * c) = o; }
    LDS_WAIT(); asm volatile("" ::: "memory");
}
__device__ __forceinline__ void convert_layer(Frame& F, const Args& A, const int Lc, const int gw, const int NGW) {
    LAS float* scr = (LAS float*)(F.lds + RING_OFF + F.wave * 16384);
    bf16* wsb = (bf16*)A.ws;
    for (int it0 = gw; it0 < 6272; it0 += NGW) {
        const int it = __builtin_amdgcn_readfirstlane(it0);
        const int L = Lc; int r = it; int slot;
        if (r < 2048) { slot = r >> 9; r &= 511; } else { r -= 2048; slot = 4 + r / 1408; r %= 1408; }
        const float* W; int ld, K, nblk, ilv = 0, row_off = 0; const float* gain = nullptr; bf16* dst;
        bf16* wl = (L < 2) ? wsb + WS_WC / 2 + (size_t)L * CONF_W_ELEMS : wsb + WS_WA / 2 + (size_t)(L - 2) * ATT_W_ELEMS;
        if (slot >= 4) {
            if (slot == 6) { W = A.in[24] + (size_t)L * FF * D; ld = D; K = FF; nblk = D / 32; dst = wl + (L < 2 ? CW_W2 : AW_W2); }
            else { W = (slot == 4 ? A.in[22] : A.in[23]) + (size_t)L * D * FF; ld = FF; K = D; nblk = FF / 32; ilv = 1; row_off = (slot == 4) ? 0 : 128; gain = A.in[21] + L * D; dst = wl + (L < 2 ? CW_W13 : AW_W13); }
        } else if (L < 2) {
            if (slot == 3) continue;
            if (slot == 2) { W = A.in[8] + (size_t)L * D * D; ld = D; K = D; nblk = D / 32; dst = wl + CW_PW2; }
            else { W = A.in[2] + (size_t)L * D * 2 * D + (slot == 1 ? D : 0); ld = 2 * D; K = D; nblk = D / 32; ilv = 1; row_off = (slot == 1) ? 128 : 0; gain = A.in[1] + L * D; dst = wl + CW_PW1; }
        } else {
            const int j = L - 2;
            if (slot == 0) { W = A.in[14] + (size_t)j * D * D; gain = A.in[13] + j * D; dst = wl + AW_QKV; }
            else if (slot == 1) { if (j) continue; W = A.in[11]; gain = A.in[10]; dst = wl + AW_QKV; row_off = 1024; }
            else if (slot == 2) { if (j) continue; W = A.in[12]; gain = A.in[10]; dst = wl + AW_QKV; row_off = 2048; }
            else { W = A.in[20] + (size_t)j * D * D; dst = wl + AW_WO; }
            ld = D; K = D; nblk = D / 32;
        }
        p0_transpose_item(W, ld, K, nblk, gain, dst, ilv, row_off, scr, r, F.lane);
    }
}
__device__ __forceinline__ void p0_prologue(Frame& F, const Args& A) {
    refresh(F);
    const int gw = F.vcu * NWAVES + F.wave, NGW = F.G * NWAVES;
    convert_layer(F, A, 0, gw, NGW);
    const float* x = A.in[0]; bf16* XB = (bf16*)(A.ws + WS_XB); float* ssq = (float*)(A.ws + WS_SSQ);
    for (int m0 = gw * 4; m0 < M; m0 += NGW * 4) {
        f32x4 v[4][4];
#pragma unroll
        for (int q = 0; q < 4; ++q)
#pragma unroll
            for (int j = 0; j < 4; ++j) v[q][j] = *((const GAS f32x4*)(x + (size_t)(m0 + q) * D) + F.lane + 64 * j);
#pragma unroll
        for (int q = 0; q < 4; ++q) { float s = 0.f;
#pragma unroll
            for (int j = 0; j < 4; ++j) s += (v[q][j].x * v[q][j].x + v[q][j].y * v[q][j].y) + (v[q][j].z * v[q][j].z + v[q][j].w * v[q][j].w);
            s = wave_sum(s);
            GAS unsigned long long* o8 = (GAS unsigned long long*)(XB + (size_t)(m0 + q) * D) + F.lane;
#pragma unroll
            for (int j = 0; j < 4; ++j) o8[64 * j] = (unsigned long long)pk2(v[q][j].x, v[q][j].y) | ((unsigned long long)pk2(v[q][j].z, v[q][j].w) << 32);
            if (F.lane == 0) *(GAS f32x4*)(ssq + (size_t)(m0 + q) * 4) = (f32x4){s, 0.f, 0.f, 0.f}; }
    }
}
__device__ __forceinline__ void final_phase(Frame& F, float* X, const float* g) {
    refresh(F);
    const int gw = F.vcu * NWAVES + F.wave, NGW = F.G * NWAVES;
    f32x4 gv[4];
#pragma unroll
    for (int j = 0; j < 4; ++j) gv[j] = *((const GAS f32x4*)g + F.lane + 64 * j);
    for (int m0 = gw * 4; m0 < M; m0 += NGW * 4) {
        f32x4 v[4][4];
#pragma unroll
        for (int q = 0; q < 4; ++q)
#pragma unroll
            for (int j = 0; j < 4; ++j) v[q][j] = *((const GAS f32x4*)(X + (size_t)(m0 + q) * D) + F.lane + 64 * j);
#pragma unroll
        for (int q = 0; q < 4; ++q) { float s = 0.f;
#pragma unroll
            for (int j = 0; j < 4; ++j) s += (v[q][j].x * v[q][j].x + v[q][j].y * v[q][j].y) + (v[q][j].z * v[q][j].z + v[q][j].w * v[q][j].w);
            const float rs = 1.0f / sqrtf(wave_sum(s) * (1.0f / D) + EPS);
#pragma unroll
            for (int j = 0; j < 4; ++j) *((GAS f32x4*)(X + (size_t)(m0 + q) * D) + F.lane + 64 * j) = v[q][j] * rs * gv[j]; }
    }
}
__device__ __forceinline__ void conv_phase(Frame& F, const bf16* G, bf16* U, const float* dww, const float* dwb, const float* lng, const float* lnb) {
    refresh(F);
    LAS float* red = (LAS float*)(F.lds + RING_OFF);
    for (int unit = F.vcu; unit < M / 32; unit += F.G) {
        int c0 = 2 * F.tid; asm volatile("" : "+v"(c0));
        f32x2 w[CW];
#pragma unroll
        for (int j = 0; j < CW; ++j) w[j] = *(const GAS f32x2*)(dww + j * D + c0);
        const int row0 = unit * 32; const bool head = ((row0 & (SEQ - 1)) == 0);
        f32x2 acc[32];
#pragma unroll
        for (int p = 0; p < 32; ++p) acc[p] = (f32x2){0.f, 0.f};
        unsigned gin[62];
        { const GAS unsigned* gp = (const GAS unsigned*)(G + (size_t)(head ? row0 : row0 - 30) * D + c0);
#pragma unroll
          for (int i = 0; i < 62; ++i) gin[i] = gp[(size_t)(head ? (i < 30 ? 0 : i - 30) : i) * (D / 2)]; }
        const float hmsk = head ? 0.0f : 1.0f;
#pragma unroll
        for (int i = 0; i < 62; ++i) {
            const float msk = (i < 30) ? hmsk : 1.0f;
            const unsigned v = gin[i];
            const f32x2 g = (f32x2){bf_lo(v) * msk, bf_hi(v) * msk};
#pragma unroll
            for (int p = (i > 30 ? i - 30 : 0); p <= (i < 31 ? i : 31); ++p) acc[p] += w[i - p] * g;
        }
        float v[64];
        const f32x2 bb = *(const GAS f32x2*)(dwb + c0), gg = *(const GAS f32x2*)(lng + c0), be = *(const GAS f32x2*)(lnb + c0);
#pragma unroll
        for (int p = 0; p < 32; ++p) { acc[p] += bb; v[p] = acc[p].x + acc[p].y; v[32 + p] = acc[p].x * acc[p].x + acc[p].y * acc[p].y; }
        bfly_round<32, 32>(v, F.lane); bfly_round<16, 16>(v, F.lane); bfly_round<8, 8>(v, F.lane); bfly_round<4, 4>(v, F.lane); bfly_round<2, 2>(v, F.lane); bfly_round<1, 1>(v, F.lane);
        __syncthreads();
        red[F.wave * 64 + F.lane] = v[0];
        __syncthreads();
        if (F.tid < 64) { float t = 0.f;
#pragma unroll
            for (int wv = 0; wv < 8; ++wv) t += red[wv * 64 + F.tid];
            red[512 + F.tid] = t; }
        __syncthreads();
#pragma unroll
        for (int p = 0; p < 32; ++p) {
            const float mean = red[512 + p] * (1.0f / D), var = red[512 + 32 + p] * (1.0f / D) - mean * mean, rs = 1.0f / sqrtf(fmaxf(var, 0.f) + EPS);
            const f32x2 y = (acc[p] - mean) * rs * gg + be;
            const float s0 = y.x * pg8::sigmoidf_(y.x), s1 = y.y * pg8::sigmoidf_(y.y);
            *(GAS unsigned*)(U + (size_t)(row0 + p) * D + c0) = pk2(s0, s1);
        }
    }
}
__device__ __forceinline__ int crow(int r, int hi) { return (r & 3) + 8 * (r >> 2) + 4 * hi; }
constexpr int AK_SLOT = 8192, AV_SLOT = 16384, A_KRING = 0, A_VRING = 3 * AK_SLOT, A_WSF = A_VRING + 3 * AV_SLOT;
constexpr float ATT_THR = 8.0f;
#define SBAR() __builtin_amdgcn_sched_barrier(0)
#define ATT_WAIT_BAR(N) asm volatile("s_waitcnt vmcnt(" #N ") lgkmcnt(0)\n\ts_barrier" ::: "memory")
__device__ __forceinline__ void glds16s(const void* sbase, unsigned voff, unsigned lds_dst) {
    unsigned keep; asm volatile("s_mov_b32 %0, m0\n\ts_mov_b32 m0, %2\n\ts_nop 0\n\tglobal_load_lds_dwordx4 %1, %3\n\ts_mov_b32 m0, %0" : "=&s"(keep) : "v"(voff), "s"(lds_dst), "s"(sbase) : "memory"); }
__device__ __forceinline__ float att_rowmax(const f32x16& p0, const f32x16& p1) {
    float a = fmaxf(fmaxf(p0[0], p0[1]), p1[0]), b = fmaxf(fmaxf(p0[2], p0[3]), p1[1]); a = fmaxf(fmaxf(a, p1[2]), p1[3]);
#pragma unroll
    for (int r = 4; r < 16; r += 4) { a = fmaxf(fmaxf(a, p0[r]), p0[r + 1]); b = fmaxf(fmaxf(b, p0[r + 2]), p0[r + 3]); a = fmaxf(fmaxf(a, p1[r]), p1[r + 1]); b = fmaxf(fmaxf(b, p1[r + 2]), p1[r + 3]); }
    return half_max(fmaxf(a, b));
}
__device__ __forceinline__ void att_mask(f32x16& p0, f32x16& p1, int kb, int tq) {
#pragma unroll
    for (int r = 0; r < 16; ++r) { const int kv = kb + (r & 3) + 8 * (r >> 2); if (kv > tq) p0[r] = -INFINITY; if (kv + 32 > tq) p1[r] = -INFINITY; }
}
__device__ __forceinline__ void att_qk(f32x16& p0, f32x16& p1, const LAS unsigned char* kp, const bf16x8 (&qr)[4], const f32x16& cin) {
    bf16x8 kf[8];
#pragma unroll
    for (int d0 = 0; d0 < 4; ++d0) { kf[2 * d0] = *(const LAS bf16x8*)(kp + d0 * 2048); kf[2 * d0 + 1] = *(const LAS bf16x8*)(kp + d0 * 2048 + 512); }
    SBAR();
#pragma unroll
    for (int d0 = 0; d0 < 4; ++d0) {
        p0 = __builtin_amdgcn_mfma_f32_32x32x16_bf16(kf[2 * d0], qr[d0], d0 == 0 ? cin : p0, 0, 0, 0); p1 = __builtin_amdgcn_mfma_f32_32x32x16_bf16(kf[2 * d0 + 1], qr[d0], d0 == 0 ? cin : p1, 0, 0, 0); }
}
__device__ __forceinline__ void att_pv(f32x16 (&o)[4], const LAS unsigned char* vp, const u32x4 (&pw)[4]) {
#pragma unroll
    for (int d0 = 0; d0 < 4; ++d0)
#pragma unroll
        for (int ks = 0; ks < 4; ++ks) {
            const s16x4 lo = __builtin_bit_cast(s16x4, __builtin_amdgcn_ds_read_tr16_b64_v4i16((LAS s16x4*)(vp + d0 * 4096 + ks * 1024)));
            const s16x4 hh = __builtin_bit_cast(s16x4, __builtin_amdgcn_ds_read_tr16_b64_v4i16((LAS s16x4*)(vp + d0 * 4096 + ks * 1024 + 512)));
            const bf16x8 vf = (bf16x8){lo[0], lo[1], lo[2], lo[3], hh[0], hh[1], hh[2], hh[3]};
            o[d0] = __builtin_amdgcn_mfma_f32_32x32x16_bf16(__builtin_bit_cast(bf16x8, pw[ks]), vf, o[d0], 0, 0, 0); }
}
typedef __bf16 bf16x2_t __attribute__((ext_vector_type(2)));
__device__ __forceinline__ unsigned cvtpk_s(float lo, float hi) { f32x2 v = {lo, hi}; return __builtin_bit_cast(unsigned, __builtin_convertvector(v, bf16x2_t)); }
__device__ __forceinline__ void att_mask_arith(f32x16& p0, f32x16& p1, int kb, int tq) {
    const float x = (float)(kb - tq);
#pragma unroll
    for (int r = 0; r < 16; ++r) { const float kr = (float)((r & 3) + 8 * (r >> 2));
        p0[r] = __builtin_fmaf(fmaxf(x + kr, 0.f), -1e30f, p0[r]); p1[r] = __builtin_fmaf(fmaxf(x + (kr + 32.0f), 0.f), -1e30f, p1[r]); }
}
__device__ __forceinline__ s16x4 att_vtr(const LAS unsigned char* p) { return __builtin_bit_cast(s16x4, __builtin_amdgcn_ds_read_tr16_b64_v4i16((LAS s16x4*)p)); }
template <bool DOEXP> __device__ __forceinline__ float att_pv_exp(f32x16 (&o)[4], const LAS unsigned char* vp, const u32x4 (&pwi)[4], f32x16& p0, f32x16& p1, u32x4 (&pwo)[4]) {
    s16x4 vl[8], vh[8]; float ls = 0.f;
#define VRD(i) do { vl[(i) & 7] = att_vtr(vp + ((i) & 3) * 4096 + ((i) >> 2) * 1024); vh[(i) & 7] = att_vtr(vp + ((i) & 3) * 4096 + ((i) >> 2) * 1024 + 512); } while (0)
#define VFR(i) (bf16x8){vl[(i) & 7][0], vl[(i) & 7][1], vl[(i) & 7][2], vl[(i) & 7][3], vh[(i) & 7][0], vh[(i) & 7][1], vh[(i) & 7][2], vh[(i) & 7][3]}
#ifndef ATT_PF
#define ATT_PF 4
#endif
#pragma unroll
    for (int i = 0; i < ATT_PF; ++i) VRD(i);
    SBAR();
#pragma unroll
    for (int i = 0; i < 16; ++i) {
        o[i & 3] = __builtin_amdgcn_mfma_f32_32x32x16_bf16(__builtin_bit_cast(bf16x8, pwi[i >> 2]), VFR(i), o[i & 3], 0, 0, 0);
        if (i + ATT_PF < 16) VRD(i + ATT_PF);
        if (DOEXP) { float e0, e1;
            if (i < 8) { e0 = __builtin_amdgcn_exp2f(p0[2 * i]); e1 = __builtin_amdgcn_exp2f(p0[2 * i + 1]); } else { e0 = __builtin_amdgcn_exp2f(p1[2 * i - 16]); e1 = __builtin_amdgcn_exp2f(p1[2 * i - 15]); }
            ls += e0; ls += e1; pwo[i >> 2][i & 3] = cvtpk_s(e0, e1);
            asm volatile("" : "+v"(ls), "+v"(pwo[i >> 2][i & 3])); }
        SBAR();
    }
#undef VRD
#undef VFR
    return ls;
}
__device__ __forceinline__ void attn_unit(Frame& F, int b, int h, int qb, const bf16* Qb, const bf16* Kb, const bf16* Vb, bf16* Ob, float* O0, float lam, float lam_init, const float* subg, const bool do_store = true) {
    const int lane = F.lane, r32 = lane & 31, hi = lane >> 5, wid = F.wave;
    LAS unsigned char* lds = F.lds + RING_OFF;
    const unsigned lds0 = (unsigned)(uintptr_t)lds;
    LAS float* wsf = (LAS float*)(lds + A_WSF) + wid * 64;
    const size_t rowbase = (size_t)b * SEQ; const int q0 = qb * 256, NT = 4 * (qb + 1);
    const int tq = q0 + 32 * wid + r32;
    const float sl2 = LOG2E * __builtin_amdgcn_exp2f(-(float)(h + 1));
    const int unit_lin = (b * NH + h) * 8 + qb;
    const LAS unsigned char* kp0 = lds + A_KRING + hi * 1024 + r32 * 16;
    const LAS unsigned char* vp0 = lds + A_VRING + ((lane >> 4) & 1) * 32 + (lane & 3) * 8 + (4 * hi + ((lane & 15) >> 2)) * 64;
    const unsigned kdst = lds0 + A_KRING + wid * 1024, vdst = lds0 + A_VRING + wid * 1024;
    const int wdiag = wid >> 1;
#pragma unroll 1
    for (int c = 0; c < 2; ++c) {
        const bf16* Qw = Qb + (rowbase + q0 + wid * 32) * D + (2 * h + c) * 64;
        const bf16* kbase = Kb + rowbase * D + (2 * h + c) * 64 + wid * 8;
        const bf16* vbase = Vb + (rowbase + 16 * (wid & 3)) * D + h * 128 + (wid >> 2) * 32;
        const unsigned kvoff = (unsigned)lane * (D * 2), vvoff = (unsigned)(lane >> 2) * (D * 2) + (unsigned)(lane & 3) * 16;
#define DMA_K(t, slot) glds16s(kbase + (size_t)(t) * 64 * D, kvoff, (unsigned)__builtin_amdgcn_readfirstlane(kdst + (slot) * AK_SLOT))
#define DMA_V(t, slot) do { glds16s(vbase + (size_t)(t) * 64 * D, vvoff, (unsigned)__builtin_amdgcn_readfirstlane(vdst + (slot) * AV_SLOT)); \
                            glds16s(vbase + 64 + (size_t)(t) * 64 * D, vvoff, (unsigned)__builtin_amdgcn_readfirstlane(vdst + (slot) * AV_SLOT + 8192)); } while (0)
        DMA_K(0, 0); DMA_V(0, 0); DMA_K(1, 1);
        bf16x8 qr[4];
#pragma unroll
        for (int d0 = 0; d0 < 4; ++d0) qr[d0] = *(const GAS bf16x8*)(Qw + (size_t)r32 * D + d0 * 16 + hi * 8);
        f32x16 o[4];
#pragma unroll
        for (int d0 = 0; d0 < 4; ++d0) o[d0] = (f32x16){};
        float mref, l_run = 0.f; u32x4 pwA[4], pwB[4]; f32x16 p0, p1;
        ATT_WAIT_BAR(3);
        DMA_K(2, 2); DMA_V(1, 1);
        {
            const f32x16 z = (f32x16){};
            att_qk(p0, p1, kp0, qr, z);
            if (NT == 4 && wdiag == 0) att_mask_arith(p0, p1, 4 * hi, tq);
            mref = att_rowmax(p0, p1);
            const float cb = sl2 * (float)(4 * hi - tq) - mref;
#pragma unroll
            for (int r = 0; r < 16; ++r) { const float kr = (float)((r & 3) + 8 * (r >> 2)); p0[r] = __builtin_fmaf(sl2, kr, p0[r]) + cb; p1[r] = __builtin_fmaf(sl2, kr + 32.0f, p1[r]) + cb; }
#pragma unroll
            for (int i = 0; i < 16; ++i) { float e0, e1;
                if (i < 8) { e0 = __builtin_amdgcn_exp2f(p0[2 * i]); e1 = __builtin_amdgcn_exp2f(p0[2 * i + 1]); } else { e0 = __builtin_amdgcn_exp2f(p1[2 * i - 16]); e1 = __builtin_amdgcn_exp2f(p1[2 * i - 15]); }
                l_run += e0; l_run += e1; pwA[i >> 2][i & 3] = cvtpk_s(e0, e1); }
        }
        ATT_WAIT_BAR(3);
        int sp = 2, sc = 0, sn = 1;
#define ATT_STEP(t, PWI, PWO) do { \
            sp = sc; sc = sn; sn = (sn == 2) ? 0 : sn + 1; \
            if ((t) + 2 < NT) DMA_K((t) + 2, sp); \
            if ((t) + 1 < NT) DMA_V((t) + 1, sn); \
            { const float cv = sl2 * (float)(64 * (t) + 4 * hi - tq) - mref; f32x16 cin; \
              _Pragma("unroll") for (int r = 0; r < 16; ++r) cin[r] = cv; \
              att_qk(p0, p1, kp0 + sc * AK_SLOT, qr, cin); } \
            _Pragma("unroll") for (int r = 0; r < 16; ++r) { const float kr = (float)((r & 3) + 8 * (r >> 2)); p0[r] = __builtin_fmaf(sl2, kr, p0[r]); p1[r] = __builtin_fmaf(sl2, kr + 32.0f, p1[r]); } \
            if ((t) >= NT - 4 && (t) - (NT - 4) >= wdiag) att_mask_arith(p0, p1, 64 * (t) + 4 * hi, tq); \
            const float rm = att_rowmax(p0, p1); \
            if (__builtin_expect(__any(rm > ATT_THR), 0)) { \
                const float dl = fmaxf(rm, 0.f), fs = __builtin_amdgcn_exp2f(-dl); mref += dl; l_run *= fs; \
                _Pragma("unroll") for (int r = 0; r < 16; ++r) { p0[r] -= dl; p1[r] -= dl; } \
                _Pragma("unroll") for (int ks = 0; ks < 4; ++ks) _Pragma("unroll") for (int k = 0; k < 4; ++k) { const unsigned wv = PWI[ks][k]; PWI[ks][k] = cvtpk_s(bf_lo(wv) * fs, bf_hi(wv) * fs); } \
                if (hi == 0) wsf[r32] = fs; \
                _Pragma("unroll") for (int r = 0; r < 16; ++r) { const float fr_ = wsf[crow(r, hi)]; _Pragma("unroll") for (int d0 = 0; d0 < 4; ++d0) o[d0][r] *= fr_; } \
            } \
            SBAR(); \
            l_run += att_pv_exp<true>(o, vp0 + sp * AV_SLOT, PWI, p0, p1, PWO); \
            if ((t) + 2 < NT) ATT_WAIT_BAR(3); else if ((t) + 1 < NT) ATT_WAIT_BAR(2); else ATT_WAIT_BAR(0); \
        } while (0)
        int t = 1;
#pragma unroll 1
        for (; t + 1 < NT; t += 2) { ATT_STEP(t, pwA, pwB); ATT_STEP(t + 1, pwB, pwA); }
        ATT_STEP(t, pwA, pwB);
#undef ATT_STEP
        (void)att_pv_exp<false>(o, vp0 + sc * AV_SLOT, pwB, p0, p1, pwA);
        asm volatile("s_waitcnt lgkmcnt(0)\n\ts_barrier" ::: "memory");
#undef DMA_K
#undef DMA_V
        l_run = half_sum(l_run);
        if (hi == 0) wsf[32 + r32] = l_run;
        float rl[16];
#pragma unroll
        for (int r = 0; r < 16; ++r) rl[r] = 1.0f / wsf[32 + crow(r, hi)];
        int ln_ = lane; asm volatile("" : "+v"(ln_));
        float* park = O0 + ((size_t)(unit_lin * 8 + wid) * 64 + ln_) * 64;
        if (c == 0) {
#pragma unroll
            for (int d0 = 0; d0 < 4; ++d0)
#pragma unroll
                for (int q = 0; q < 4; ++q) *(GAS f32x4*)(park + d0 * 16 + q * 4) = (f32x4){o[d0][4 * q] * rl[4 * q], o[d0][4 * q + 1] * rl[4 * q + 1], o[d0][4 * q + 2] * rl[4 * q + 2], o[d0][4 * q + 3] * rl[4 * q + 3]};
        } else {
            asm volatile("s_waitcnt vmcnt(0)" ::: "memory");
            float ss[16];
#pragma unroll
            for (int r = 0; r < 16; ++r) ss[r] = 0.f;
#pragma unroll
            for (int d0 = 0; d0 < 4; ++d0)
#pragma unroll
                for (int q = 0; q < 4; ++q) { const f32x4 pk = *(const GAS f32x4*)(park + d0 * 16 + q * 4);
#pragma unroll
                    for (int i = 0; i < 4; ++i) { const int r = 4 * q + i; const float v = pk[i] - lam * (o[d0][r] * rl[r]); o[d0][r] = v; ss[r] += v * v; } }
#pragma unroll
            for (int r = 0; r < 16; ++r) {
                ss[r] += shx<1>(ss[r]); ss[r] += shx<2>(ss[r]); ss[r] += shx<4>(ss[r]); ss[r] += shx<8>(ss[r]); ss[r] += shx<16>(ss[r]);
                ss[r] = (1.0f - lam_init) / sqrtf(ss[r] * (1.0f / 128.0f) + EPS); }
            float gsub[4];
#pragma unroll
            for (int d0 = 0; d0 < 4; ++d0) gsub[d0] = subg[32 * d0 + r32];
            bf16* Ow = Ob + (rowbase + q0 + wid * 32 + 4 * hi + 2) * D + h * 128 + r32;
            if (do_store)
#pragma unroll
            for (int g = 0; g < 4; ++g) { asm volatile("" : "+v"(Ow));
#pragma unroll
                for (int i = 0; i < 4; ++i)
#pragma unroll
                    for (int d0 = 0; d0 < 4; ++d0) Ow[(i - 2) * D + 32 * d0] = (bf16)f2bf(o[d0][4 * g + i] * ss[4 * g + i] * gsub[d0]);
                Ow += 8 * D; }
        }
        __syncthreads();
    }
}
__device__ __forceinline__ void attn_phase(Frame& F, const Args& A, int j, float lam_init) {
    refresh(F);
    const bf16* Qb = (const bf16*)(A.ws + WS_QO); const bf16* Kb = (const bf16*)(A.ws + WS_K); const bf16* Vb = (const bf16*)(A.ws + WS_V);
    bf16* Ob = (bf16*)(A.ws + WS_QO); float* O0 = (float*)(A.ws + WS_O0);
    const float a = wave_sum(A.in[15][j * 64 + F.lane] * A.in[16][j * 64 + F.lane]), b2 = wave_sum(A.in[17][j * 64 + F.lane] * A.in[18][j * 64 + F.lane]);
    const float lam = expf(a) - expf(b2) + lam_init;
    const float* subg = A.in[19] + j * 128;
    for (int w = 2 * F.vcu; w < NB * NH * 8; w += 2 * F.G) {
#pragma unroll 1
        for (int e = 0; e < 2; ++e) { const int ww = w + e, bh = ww >> 3, k = ww & 7, qb = (k & 1) ? 7 - (k >> 1) : (k >> 1);
#if (PROBE_REP >> 4) & 1
            attn_unit(F, bh >> 3, bh & 7, qb, Qb, Kb, Vb, Ob, O0, lam, lam_init, subg, false);
#endif
            attn_unit(F, bh >> 3, bh & 7, qb, Qb, Kb, Vb, Ob, O0, lam, lam_init, subg); }
    }
}

__global__ void __launch_bounds__(NWAVES * 64, 2) yoco_fwd(Args args) {
    extern __shared__ __attribute__((aligned(16))) unsigned char lds_raw[];
    Frame F;
    F.lds = (LAS unsigned char*)lds_raw;
    F.MISC = (volatile LAS unsigned*)(F.lds + MISC_OFF);
    F.tid = threadIdx.x; F.lane = F.tid & 63; F.wave = __builtin_amdgcn_readfirstlane(F.tid >> 6);
    F.G = gridDim.x; { const int bx = blockIdx.x; F.vcu = (F.G % 8 == 0) ? (bx % 8) * (F.G / 8) + bx / 8 : bx; }
    unsigned char* ws = args.ws;
    F.ctl = (gu32*)(ws + WS_CTL);
    for (int u = F.tid; u < (LDS_BYTES - LDSCTL_OFF) / 4; u += NWAVES * 64) ((LAS unsigned*)(F.lds + LDSCTL_OFF))[u] = 0u;
    __syncthreads();
    const int lo = args.ph_lo, hi = args.ph_hi;
    XcdBarrier bar; bar.bar = (unsigned*)F.ctl; bar.x = 0; bar.st = nullptr;
    if (hi - lo > 1) bar = xcd_barrier_post((unsigned*)F.ctl, F.MISC + 8, F.tid == 0);

    bf16* wsb = (bf16*)ws;
    bf16* XB = (bf16*)(ws + WS_XB); float* SSQ = (float*)(ws + WS_SSQ); float* X = args.out;
#pragma unroll 1
    for (int ph = lo; ph < hi; ++ph) {
#if PROBE_REP
      int kind_ = 0; if (ph == 0) kind_ = 0; else if (ph == N_PHASES - 1) kind_ = 15; else { const int L_ = (ph - 1) / 5, k_ = (ph - 1) % 5; kind_ = (k_ == 0) ? (L_ < 2 ? 1 : 3) : (k_ == 1) ? (L_ < 2 ? 2 : 4) : (k_ == 3) ? 5 : 15; }
      const int reps_ = 1 + ((kind_ != 4) && ((PROBE_REP >> kind_) & 1));
#pragma unroll 1
      for (int rep_ = 0; rep_ < reps_; ++rep_) {
        if (rep_) xcd_barrier(bar, F.wave == 0 && fresh_lane() == 0);
#endif
        if (ph == 0) p0_prologue(F, args);
        else if (ph == N_PHASES - 1) final_phase(F, X, args.in[25]);
        else {
            const int L = (ph - 1) / 5, k = (ph - 1) % 5;
            bf16* wl = (L < 2) ? wsb + WS_WC / 2 + (size_t)L * CONF_W_ELEMS : wsb + WS_WA / 2 + (size_t)(L - 2) * ATT_W_ELEMS;
            if (k == 0 && L < 2) {
                pg8::Gemm g{XB, wl + CW_PW1, M, 2 * D, D}; pg8::StaticOrder S; S.init(M, 2 * D, F.G, (int)blockIdx.x);
                pg8::EpiGate<0> E{(bf16*)(ws + WS_G), D, SSQ, args.in[3] + L * 2 * D};
                pg8::gemm_phase<pg8::EpiGate<0>, pg8::StaticOrder, true, true>(F.lds + RING_OFF, g, S, E, F.wave);
            } else if (k == 0) {
                const int N = (L == 2) ? 3 * D : D;
                pg8::Gemm g{XB, wl + AW_QKV, M, N, D}; pg8::StaticOrder S; S.init(M, N, F.G, (int)blockIdx.x);
                typedef pg8::EpiQKV<WS_QO, WS_K, WS_V> EQ; EQ E{ws, SSQ, QSCALE};
                pg8::gemm_phase<EQ, pg8::StaticOrder, true, true>(F.lds + RING_OFF, g, S, E, F.wave);
            } else if (k == 1 && L < 2) {
                conv_phase(F, (const bf16*)(ws + WS_G), (bf16*)(ws + WS_U), args.in[4] + L * CW * D, args.in[5] + L * D, args.in[6] + L * D, args.in[7] + L * D);
            } else if (k == 1) {
                attn_phase(F, args, L - 2, L == 2 ? args.lam_init2 : args.lam_init3);
            } else if (k == 3) {
                pg8::Gemm g{XB, wl + (L < 2 ? CW_W13 : AW_W13), M, NFF2, D}; pg8::StaticOrder S; S.init(M, NFF2, F.G, (int)blockIdx.x);
                pg8::EpiGate<1> E{(bf16*)(ws + WS_H), FF, SSQ, nullptr};
                pg8::gemm_phase<pg8::EpiGate<1>, pg8::StaticOrder, true, true>(F.lds + RING_OFF, g, S, E, F.wave);
                { pg8::Unit u_; const int nfull = (M / 256) * (NFF2 / 256) / F.G, nrem = (M / 256) * (NFF2 / 256) % F.G;
                  if (L < 3 && nrem && !S.next(nfull, u_)) { refresh(F); convert_layer(F, args, L + 1, ((int)blockIdx.x - nrem) * NWAVES + F.wave, (F.G - nrem) * NWAVES); }
                  else if (L < 3 && !nrem) { refresh(F); convert_layer(F, args, L + 1, F.vcu * NWAVES + F.wave, F.G * NWAVES); } }
            } else {
                const bf16* Aop; const bf16* Bop; int K; const float* bias = nullptr; const float* base = X;
                if (k == 4) { Aop = (const bf16*)(ws + WS_H); Bop = wl + (L < 2 ? CW_W2 : AW_W2); K = FF; }
                else if (L < 2) { Aop = (const bf16*)(ws + WS_U); Bop = wl + CW_PW2; K = D; bias = args.in[9] + L * D; if (L == 0) base = args.in[0]; }
                else { Aop = (const bf16*)(ws + WS_QO); Bop = wl + AW_WO; K = D; }
                pg8::Gemm g{Aop, Bop, M, D, K}; pg8::StaticOrder S; S.init(M, D, F.G, (int)blockIdx.x);
                pg8::EpiRes E{base, X, XB, SSQ, bias};
                if (F.G == 256) pg8::gemm_phase<pg8::EpiRes, pg8::StaticOrder, false, true>(F.lds + RING_OFF, g, S, E, F.wave);
            }
        }
#if PROBE_REP
      }
      if ((PROBE_REP >> 6) & 1) { if (ph + 1 < hi) xcd_barrier(bar, F.wave == 0 && fresh_lane() == 0); }
#endif
        if (ph + 1 < hi) xcd_barrier(bar, F.wave == 0 && fresh_lane() == 0);
    }
}

#ifndef MK_ONE_LAUNCH
#define MK_ONE_LAUNCH 0
#endif
extern "C" void kernel_launch(void* const* d_in, const int* in_sizes, int n_in, void* d_out, int out_size, void* d_ws, size_t ws_size, hipStream_t stream) {
    static int grid = 0;
    if (grid == 0) {
        if (n_in != 26 || in_sizes[0] != M * D || out_size != M * D || ws_size < WS_END) { fprintf(stderr, "kernel_launch: unexpected shapes (n_in %d, in0 %d, out %d, ws %zu); nothing launched\n", n_in, n_in > 0 ? in_sizes[0] : -1, out_size, ws_size); grid = -1; return; }
        int dev = 0, cus = 0, per_cu = 0;
        if (hipGetDevice(&dev) != hipSuccess || hipDeviceGetAttribute(&cus, hipDeviceAttributeMultiprocessorCount, dev) != hipSuccess) { grid = -1; return; }
        if (hipFuncSetAttribute((const void*)yoco_fwd, hipFuncAttributeMaxDynamicSharedMemorySize, LDS_BYTES) != hipSuccess) { fprintf(stderr, "kernel_launch: hipFuncSetAttribute failed\n"); grid = -1; return; }
        if (hipOccupancyMaxActiveBlocksPerMultiprocessor(&per_cu, (const void*)yoco_fwd, NWAVES * 64, LDS_BYTES) != hipSuccess || per_cu < 1) { fprintf(stderr, "kernel_launch: occupancy query says %d blocks per CU\n", per_cu); }
        (void)hipGetLastError();
        grid = cus;
        if (grid != 256) fprintf(stderr, "kernel_launch: %d CUs; the residual GEMM phases need exactly 256 workgroups\n", grid);
    }
    if (grid < 0) return;
    if (hipMemsetAsync((char*)d_ws + WS_CTL, 0, CTL_ZERO_BYTES, stream) != hipSuccess) return;
    Args a{};
    for (int i = 0; i < 26; ++i) a.in[i] = (const float*)d_in[i];
    a.out = (float*)d_out; a.ws = (unsigned char*)d_ws;
    a.lam_init2 = (float)(0.8 - 0.6 * exp(-0.3 * 2.0)); a.lam_init3 = (float)(0.8 - 0.6 * exp(-0.3 * 3.0));
#if MK_ONE_LAUNCH
    a.ph_lo = 0; a.ph_hi = N_PHASES;
    hipLaunchKernelGGL(yoco_fwd, dim3(grid), dim3(NWAVES * 64), LDS_BYTES, stream, a);
#else
    for (int p = 0; p < N_PHASES; ++p) { a.ph_lo = p; a.ph_hi = p + 1; hipLaunchKernelGGL(yoco_fwd, dim3(grid), dim3(NWAVES * 64), LDS_BYTES, stream, a); }
#endif
}
```

```cpp
#define MK_ONE_LAUNCH 1
#define PROBE_REP 0
#include <hip/hip_runtime.h>
#include <cstdio>
#include <cstdint>
#include <cmath>
namespace pg8 {
#define PG8_LAS __attribute__((address_space(3)))
typedef unsigned short bf16_t;
typedef short bf16x8 __attribute__((ext_vector_type(8)));
typedef float f32x4 __attribute__((ext_vector_type(4)));
typedef unsigned u32x4 __attribute__((ext_vector_type(4)));
constexpr int BM = 256, BK = 64, HALF = 128, HTB = HALF * BK * 2  , STAGE_BYTES = 8 * HTB, NXCD = 8, WGM = 8;

__host__ __device__ __forceinline__ int lds_byte(int r, int c) { const int st = (r >> 4) * 2 + (c >> 5), rr = r & 15, cc = c & 31, ob = rr * 64 + cc * 2; return st * 1024 + (ob ^ (((ob >> 9) & 1) << 5)); }
__host__ __device__ __forceinline__ void stage_rc(int b, int& R, int& C) { const int st = b / 1024, sb = b % 1024, swz = sb ^ (((sb >> 9) & 1) << 5); R = (st >> 1) * 16 + swz / 64; C = (st & 1) * 32 + (swz % 64) / 2; }
__host__ __device__ __forceinline__ int perm32(int rho) { const int n = rho >> 4, i = rho & 15; return 8 * (i >> 2) + 4 * n + (i & 3); }

struct Unit { int pm, pn; };
struct Gemm { const bf16_t* A; const bf16_t* Bt; int M, N, K; };

struct StaticOrder {
    int nM, nN, nwg, G, c;
    __host__ __device__ void init(int M, int N, int G_, int c_) { nM = M / BM; nN = N / BM; nwg = nM * nN; G = G_; c = c_; }
    __host__ __device__ bool next(int i, Unit& u) const {
        const long L = (long)i * G + c; if (L >= nwg) return false;
        int wgid = (int)L; { const int q = nwg / NXCD, r = nwg % NXCD, xcd = wgid % NXCD, off = wgid / NXCD; wgid = (xcd < r ? xcd * (q + 1) : r * (q + 1) + (xcd - r) * q) + off; }
        const int nig = WGM * nN, gid = wgid / nig, fm = gid * WGM, gsz = (nM - fm) < WGM ? (nM - fm) : WGM;
        u.pm = fm + ((wgid % nig) % gsz); u.pn = (wgid % nig) / gsz; return true;
    }
    __device__ __forceinline__ void a_ready(const Unit&) const {}
    __device__ __forceinline__ void done(const Unit&) const {}
};

__device__ __forceinline__ unsigned cvt_pk_bf16(float lo, float hi) { unsigned r; asm volatile("v_cvt_pk_bf16_f32 %0, %1, %2" : "=v"(r) : "v"(lo), "v"(hi)); return r; }
typedef unsigned u32x2 __attribute__((ext_vector_type(2)));
constexpr float NORM_EPS = 1e-6f;
__device__ __forceinline__ float row_rstd(const float* ssq, int row) { const f32x4 s = *(const f32x4*)(ssq + (size_t)row * 4); return __builtin_amdgcn_rsqf(((s[0] + s[1]) + (s[2] + s[3])) * (1.0f / 1024.0f) + NORM_EPS); }
__device__ __forceinline__ float sigmoidf_(float x) { return __builtin_amdgcn_rcpf(1.0f + __builtin_amdgcn_exp2f(-1.4426950408889634f * x)); }

template <int MODE> struct EpiGate {
    static constexpr bool PERM = true, AFTER_DRAIN = false;
    bf16_t* O; int ldc; const float* ssq; const float* bias;
    __device__ __forceinline__ void operator()(const f32x4 (&acc)[2][2][4][2], const Unit& u, int wr, int wc, int fr, int fq) const {
        const int row0 = u.pm * BM + wr * 64 + fr, ch0 = u.pn * HALF + wc * 32 + 8 * fq;
        f32x4 ba[2], bg[2];
#pragma unroll
        for (int n = 0; n < 2; ++n) {
            if (MODE == 0) { ba[n] = *(const f32x4*)(bias + ch0 + 4 * n); bg[n] = *(const f32x4*)(bias + 1024 + ch0 + 4 * n); }
            else { ba[n] = (f32x4){0.f, 0.f, 0.f, 0.f}; bg[n] = (f32x4){0.f, 0.f, 0.f, 0.f}; } }
        float rsv[2][4];
#pragma unroll
        for (int ai = 0; ai < 2; ++ai)
#pragma unroll
            for (int m = 0; m < 4; ++m) rsv[ai][m] = row_rstd(ssq, row0 + ai * HALF + m * 16);
        asm volatile("" ::: "memory");
#pragma unroll
        for (int ai = 0; ai < 2; ++ai)
#pragma unroll
            for (int m = 0; m < 4; ++m) { const int row = row0 + ai * HALF + m * 16; const float rs = rsv[ai][m];
                u32x4 w;
#pragma unroll
                for (int n = 0; n < 2; ++n) { const f32x4 a = acc[ai][0][m][n] * rs + ba[n], g = acc[ai][1][m][n] * rs + bg[n]; f32x4 y;
#pragma unroll
                    for (int i = 0; i < 4; ++i) y[i] = (MODE == 0) ? a[i] * sigmoidf_(g[i]) : (a[i] * sigmoidf_(a[i])) * g[i];
                    w[2 * n] = cvt_pk_bf16(y[0], y[1]); w[2 * n + 1] = cvt_pk_bf16(y[2], y[3]); }
                *(u32x4*)(O + (size_t)row * ldc + ch0) = w; asm volatile("" ::: "memory"); }
    }
};
template <size_t OFFQ, size_t OFFK, size_t OFFV> struct EpiQKV {
    static constexpr bool PERM = true, AFTER_DRAIN = false;
    unsigned char* ws; const float* ssq; float qscale;
    __device__ __forceinline__ void operator()(const f32x4 (&acc)[2][2][4][2], const Unit& u, int wr, int wc, int fr, int fq) const {
        const int row0 = u.pm * BM + wr * 64 + fr; int colt = u.pn * BM; const int t = colt >> 10; colt &= 1023;
        const size_t boff = (t == 0 ? OFFQ : 0) + (t == 1 ? OFFK : 0) + (t == 2 ? OFFV : 0);
        bf16_t* base = (bf16_t*)(ws + boff); const float sc = (t == 0) ? qscale : 1.0f;
        const int col0 = colt + wc * 32 + 8 * fq;
        float rsv[2][4];
#pragma unroll
        for (int ai = 0; ai < 2; ++ai)
#pragma unroll
            for (int m = 0; m < 4; ++m) rsv[ai][m] = row_rstd(ssq, row0 + ai * HALF + m * 16) * sc;
        asm volatile("" ::: "memory");
#pragma unroll
        for (int ai = 0; ai < 2; ++ai)
#pragma unroll
            for (int m = 0; m < 4; ++m) { const int row = row0 + ai * HALF + m * 16; const float rs = rsv[ai][m]; bf16_t* rowp = base + (size_t)row * 1024 + col0;
#pragma unroll
                for (int bj = 0; bj < 2; ++bj) { const f32x4 v0 = acc[ai][bj][m][0] * rs, v1 = acc[ai][bj][m][1] * rs; u32x4 w;
                    w.x = cvt_pk_bf16(v0[0], v0[1]); w.y = cvt_pk_bf16(v0[2], v0[3]); w.z = cvt_pk_bf16(v1[0], v1[1]); w.w = cvt_pk_bf16(v1[2], v1[3]);
                    *(u32x4*)(rowp + bj * HALF) = w; } asm volatile("" ::: "memory"); }
    }
};
struct EpiRes {
    static constexpr bool PERM = false, AFTER_DRAIN = true;
    bf16_t* xb; float* out32; float* ssq; const float* bias;
    __device__ __forceinline__ void fused(f32x4 (&acc)[2][2][4][2], const Unit& u, int wr, int wc, int fr, int fq, PG8_LAS unsigned char* lds, int wid, int lane) const {
        const int col0 = u.pn * BM + wc * 32 + 4 * fq;
        PG8_LAS float* P = (PG8_LAS float*)lds;
        f32x4 bv[2][2];
#pragma unroll
        for (int bj = 0; bj < 2; ++bj)
#pragma unroll
            for (int n = 0; n < 2; ++n) bv[bj][n] = bias ? *(const f32x4*)(bias + col0 + bj * HALF + n * 16) : (f32x4){0.f, 0.f, 0.f, 0.f};
#pragma unroll
        for (int ai = 0; ai < 2; ++ai)
#pragma unroll
            for (int m = 0; m < 4; ++m) { const int r = ai * HALF + wr * 64 + m * 16 + fr; const size_t off = (size_t)(u.pm * BM + r) * 1024 + col0; float ss = 0.f;
#pragma unroll
                for (int bj = 0; bj < 2; ++bj)
#pragma unroll
                    for (int n = 0; n < 2; ++n) { const size_t c = off + bj * HALF + n * 16; const u32x2 bw = *(const u32x2*)(xb + c);
                        const f32x4 bs = (f32x4){__uint_as_float(bw.x << 16), __uint_as_float(bw.x & 0xffff0000u), __uint_as_float(bw.y << 16), __uint_as_float(bw.y & 0xffff0000u)};
                        const f32x4 o = bs + acc[ai][bj][m][n] + bv[bj][n];
                        if (out32) *(f32x4*)(out32 + c) = o; else { u32x2 w; w.x = cvt_pk_bf16(o[0], o[1]); w.y = cvt_pk_bf16(o[2], o[3]); *(u32x2*)(xb + c) = w; }
                        ss += (o[0] * o[0] + o[1] * o[1]) + (o[2] * o[2] + o[3] * o[3]); }
                ss += __int_as_float(__builtin_amdgcn_ds_swizzle(__float_as_int(ss), (16 << 10) | 0x1f));
                { auto rr = __builtin_amdgcn_permlane32_swap(__float_as_uint(ss), __float_as_uint(ss), false, false); ss = __uint_as_float(rr[0]) + __uint_as_float(rr[1]); }
                if (fq == 0) P[r * 4 + wc] = ss;
                if (m & 1) asm volatile("" ::: "memory"); }
        asm volatile("s_waitcnt lgkmcnt(0)" ::: "memory"); __builtin_amdgcn_s_barrier(); asm volatile("" ::: "memory");
        const int tid = wid * 64 + lane;
        if (tid < 256) { const PG8_LAS f32x4* P4 = (const PG8_LAS f32x4*)lds; const f32x4 p = P4[tid]; ssq[(size_t)(u.pm * BM + tid) * 4 + u.pn] = (p[0] + p[1]) + (p[2] + p[3]); }
    }
};

template <class Epi, class Sched, bool ALIGN_EPI = false, bool SP2 = false>
__device__ __forceinline__ void gemm_phase(PG8_LAS unsigned char* lds, const Gemm g, const Sched& S, const Epi& E, const int wave_id) {
    unsigned msk_ = ~0u; asm volatile("" : "+s"(msk_)); int tid_ = (int)__builtin_amdgcn_mbcnt_hi(msk_, __builtin_amdgcn_mbcnt_lo(msk_, 0u)); asm volatile("" : "+v"(tid_)); tid_ |= wave_id << 6;
    const int tid = tid_, wid = __builtin_amdgcn_readfirstlane(tid >> 6), lane = tid & 63, wr = wid >> 2, wc = wid & 3, fr = lane & 15, fq = lane >> 4;
    const int K = g.K, nt = K / BK;
    unsigned voffA[2], voffB[2];
#pragma unroll
    for (int i = 0; i < 2; ++i) { int R, C; stage_rc(tid * 16 + i * 8192, R, C); const int Rb = Epi::PERM ? ((R & ~31) + perm32(R & 31)) : R;
        voffA[i] = (unsigned)(R * K + C) * 2u; voffB[i] = (unsigned)(Rb * K + C) * 2u; }
    const size_t kstep = (size_t)(BK * 2);
    const size_t hstep = (size_t)HALF * K * 2;
    const size_t tstep = 2 * hstep;
    const unsigned ldsw = (unsigned)wid * 1024u;
    const int aoff = lds_byte(wr * 64 + fr, fq * 8), boff = lds_byte(wc * 32 + fr, fq * 8);
#define PG8_SA(b, h) (((b) * 2 + (h)) * HTB)
#define PG8_SB(b, h) ((4 + (b) * 2 + (h)) * HTB)
#define PG8_STAGE(bufoff, gbase, voff) do { _Pragma("unroll") for (int _i = 0; _i < 2; ++_i) \
        __builtin_amdgcn_global_load_lds((const unsigned*)((const char*)(gbase) + (voff)[_i]), (PG8_LAS unsigned*)(lds + (bufoff) + ldsw + _i * 8192), 16, 0, 0); } while (0)
#define PG8_LDA(dst, b, h) do { _Pragma("unroll") for (int m = 0; m < 4; ++m) _Pragma("unroll") for (int k = 0; k < 2; ++k) dst[m][k] = *(const PG8_LAS bf16x8*)(lds + PG8_SA(b, h) + aoff + m * 2048 + k * 1024); } while (0)
#define PG8_LDB(dst, b, h) do { _Pragma("unroll") for (int n = 0; n < 2; ++n) _Pragma("unroll") for (int k = 0; k < 2; ++k) dst[n][k] = *(const PG8_LAS bf16x8*)(lds + PG8_SB(b, h) + boff + n * 2048 + k * 1024); } while (0)
#define PG8_MMA(ai, bj, At, Bt) do { __builtin_amdgcn_s_setprio(1); _Pragma("unroll") for (int m = 0; m < 4; ++m) _Pragma("unroll") for (int n = 0; n < 2; ++n) _Pragma("unroll") for (int k = 0; k < 2; ++k) \
        acc[ai][bj][m][n] = __builtin_amdgcn_mfma_f32_16x16x32_bf16(Bt[n][k], At[m][k], acc[ai][bj][m][n], 0, 0, 0); __builtin_amdgcn_s_setprio(0); } while (0)
#define PG8_WAIT_V(n) asm volatile("s_waitcnt vmcnt(" #n ")" ::: "memory")
#define PG8_WAIT_L(n) asm volatile("s_waitcnt lgkmcnt(" #n ")" ::: "memory")
#define PG8_BAR __builtin_amdgcn_s_barrier()
#define PG8_SCHED __builtin_amdgcn_sched_barrier(0)
    Unit cur, nxt; int ui = 0;
    if (!S.next(0, cur)) return;
    f32x4 acc[2][2][4][2];
#pragma unroll
    for (int a = 0; a < 2; ++a)
#pragma unroll
        for (int b = 0; b < 2; ++b)
#pragma unroll
            for (int m = 0; m < 4; ++m)
#pragma unroll
                for (int n = 0; n < 2; ++n) acc[a][b][m][n] = (f32x4){0.f, 0.f, 0.f, 0.f};
    bf16x8 At[4][2], B0[2][2], B1[2][2];
    const char* cA = (const char*)g.A + (size_t)cur.pm * tstep; const char* cB = (const char*)g.Bt + (size_t)cur.pn * tstep;
    S.a_ready(cur);
    if constexpr (SP2) {
        PG8_STAGE(PG8_SB(0, 0), cB, voffB); PG8_STAGE(PG8_SB(0, 1), cB + hstep, voffB); PG8_STAGE(PG8_SA(0, 0), cA, voffA); PG8_STAGE(PG8_SA(0, 1), cA + hstep, voffA);
        if (wr == 1) PG8_BAR;
        PG8_WAIT_V(2); PG8_BAR;
        PG8_STAGE(PG8_SB(1, 0), cB + kstep, voffB); PG8_STAGE(PG8_SA(1, 0), cA + kstep, voffA); PG8_STAGE(PG8_SB(1, 1), cB + hstep + kstep, voffB);
        PG8_WAIT_V(6); PG8_BAR;
    } else {
        PG8_STAGE(PG8_SB(0, 0), cB, voffB); PG8_STAGE(PG8_SA(0, 0), cA, voffA); PG8_STAGE(PG8_SB(0, 1), cB + hstep, voffB); PG8_STAGE(PG8_SA(0, 1), cA + hstep, voffA);
        if (wr == 1) PG8_BAR;
        PG8_WAIT_V(4); PG8_BAR;
        PG8_STAGE(PG8_SB(1, 0), cB + kstep, voffB); PG8_STAGE(PG8_SA(1, 0), cA + kstep, voffA); PG8_STAGE(PG8_SB(1, 1), cB + hstep + kstep, voffB);
        PG8_WAIT_V(6); PG8_BAR;
    }
    for (;;) {
        const bool has_next = S.next(ui + 1, nxt);
        const char* nA = has_next ? (const char*)g.A + (size_t)nxt.pm * tstep : cA; const char* nB = has_next ? (const char*)g.Bt + (size_t)nxt.pn * tstep : cB;
        for (int t = 0; t < nt; t += 2) {
            const bool last = (t == nt - 2);
            const char* a1 = cA + (size_t)(t + 1) * kstep;
            const char* a2 = last ? nA : cA + (size_t)(t + 2) * kstep; const char* b2 = last ? nB : cB + (size_t)(t + 2) * kstep;
            const char* a3 = a2 + kstep; const char* b3 = b2 + kstep;
            if (last && has_next) S.a_ready(nxt);
            if constexpr (SP2) {
            PG8_LDB(B0, 0, 0); PG8_LDB(B1, 0, 1); PG8_SCHED; PG8_LDA(At, 0, 0); PG8_STAGE(PG8_SA(1, 1), a1 + hstep, voffA);
            PG8_WAIT_V(8); PG8_WAIT_L(0); PG8_BAR; PG8_MMA(0, 0, At, B0); PG8_MMA(0, 1, At, B1); PG8_BAR; PG8_SCHED;
            PG8_LDA(At, 0, 1); PG8_STAGE(PG8_SB(0, 0), b2, voffB); PG8_STAGE(PG8_SB(0, 1), b2 + hstep, voffB); PG8_STAGE(PG8_SA(0, 0), a2, voffA);
            PG8_WAIT_V(8); PG8_WAIT_L(0); PG8_BAR; PG8_MMA(1, 0, At, B0); PG8_MMA(1, 1, At, B1); PG8_BAR; PG8_SCHED;
            PG8_LDB(B0, 1, 0); PG8_LDB(B1, 1, 1); PG8_SCHED; PG8_LDA(At, 1, 0); PG8_STAGE(PG8_SA(0, 1), a2 + hstep, voffA);
            PG8_WAIT_V(8); PG8_WAIT_L(0); PG8_BAR; PG8_MMA(0, 0, At, B0); PG8_MMA(0, 1, At, B1); PG8_BAR; PG8_SCHED;
            PG8_LDA(At, 1, 1); PG8_STAGE(PG8_SB(1, 0), b3, voffB); PG8_STAGE(PG8_SB(1, 1), b3 + hstep, voffB); PG8_STAGE(PG8_SA(1, 0), a3, voffA);
            PG8_WAIT_V(8); PG8_WAIT_L(0); PG8_BAR; PG8_MMA(1, 0, At, B0); PG8_MMA(1, 1, At, B1); PG8_BAR; PG8_SCHED;
            } else {
            PG8_LDB(B0, 0, 0); PG8_SCHED; PG8_LDA(At, 0, 0); PG8_STAGE(PG8_SA(1, 1), a1 + hstep, voffA);
            PG8_WAIT_L(8); PG8_BAR; PG8_WAIT_L(0); PG8_MMA(0, 0, At, B0); PG8_BAR; PG8_SCHED;
            PG8_LDB(B1, 0, 1); PG8_STAGE(PG8_SB(0, 0), b2, voffB);
            PG8_BAR; PG8_WAIT_L(0); PG8_MMA(0, 1, At, B1); PG8_BAR;
            PG8_LDA(At, 0, 1); PG8_STAGE(PG8_SA(0, 0), a2, voffA);
            PG8_BAR; PG8_WAIT_L(0); PG8_MMA(1, 0, At, B0); PG8_BAR; PG8_SCHED;
            PG8_STAGE(PG8_SB(0, 1), b2 + hstep, voffB);
            PG8_WAIT_V(6); PG8_BAR; PG8_MMA(1, 1, At, B1); PG8_BAR;
            PG8_LDB(B0, 1, 0); PG8_SCHED; PG8_LDA(At, 1, 0); PG8_STAGE(PG8_SA(0, 1), a2 + hstep, voffA);
            PG8_WAIT_L(8); PG8_BAR; PG8_WAIT_L(0); PG8_MMA(0, 0, At, B0); PG8_BAR; PG8_SCHED;
            PG8_LDB(B1, 1, 1); PG8_STAGE(PG8_SB(1, 0), b3, voffB);
            PG8_BAR; PG8_WAIT_L(0); PG8_MMA(0, 1, At, B1); PG8_BAR;
            PG8_LDA(At, 1, 1); PG8_STAGE(PG8_SA(1, 0), a3, voffA);
            PG8_BAR; PG8_WAIT_L(0); PG8_MMA(1, 0, At, B0); PG8_BAR; PG8_SCHED;
            PG8_STAGE(PG8_SB(1, 1), b3 + hstep, voffB);
            PG8_WAIT_V(6); PG8_BAR; PG8_MMA(1, 1, At, B1); PG8_BAR;
            }
        }
        if constexpr (ALIGN_EPI) { if (wr == 0) PG8_BAR; }
        if constexpr (!Epi::AFTER_DRAIN) { E(acc, cur, wr, wc, fr, fq); S.done(cur); }
        if (!has_next) break;
#pragma unroll
        for (int a = 0; a < 2; ++a)
#pragma unroll
            for (int b = 0; b < 2; ++b)
#pragma unroll
                for (int m = 0; m < 4; ++m)
#pragma unroll
                    for (int n = 0; n < 2; ++n) acc[a][b][m][n] = (f32x4){0.f, 0.f, 0.f, 0.f};
        cur = nxt; cA = nA; cB = nB; ++ui;
        if constexpr (ALIGN_EPI) { if (wr == 1) PG8_BAR; }
    }
    PG8_WAIT_V(0);
    if constexpr (!ALIGN_EPI) { if (wr == 0) PG8_BAR; }
    PG8_BAR;
    if constexpr (Epi::AFTER_DRAIN) { E.fused(acc, cur, wr, wc, fr, fq, lds, wid, lane); S.done(cur); }
#undef PG8_SA
#undef PG8_SB
#undef PG8_STAGE
#undef PG8_LDA
#undef PG8_LDB
#undef PG8_MMA
#undef PG8_WAIT_V
#undef PG8_WAIT_L
#undef PG8_BAR
#undef PG8_SCHED
}
}
#define GAS __attribute__((address_space(1)))
#define LAS __attribute__((address_space(3)))
typedef unsigned short bf16;
typedef unsigned v4u __attribute__((ext_vector_type(4)));
typedef float f32x4 __attribute__((ext_vector_type(4)));
typedef short bf16x8 __attribute__((ext_vector_type(8)));
typedef GAS unsigned gu32;
typedef GAS unsigned long long gu64;
#define RLX_AGENT __ATOMIC_RELAXED, __HIP_MEMORY_SCOPE_AGENT
#define LDS_WAIT() asm volatile("s_waitcnt lgkmcnt(0)" ::: "memory")
#define VM_WAIT() asm volatile("s_waitcnt vmcnt(0)" ::: "memory")
__device__ __forceinline__ unsigned long long rt() { return __builtin_amdgcn_s_memrealtime(); }
__device__ __forceinline__ unsigned f2bf(float f) { unsigned u = __builtin_bit_cast(unsigned, f); return (u + 0x7fffu + ((u >> 16) & 1u)) >> 16; }
__device__ __forceinline__ unsigned pk2(float lo, float hi) { return f2bf(lo) | (f2bf(hi) << 16); }

#define XB_TMO      128
#define XB_XCNT(j)  (256  + 64 * (j))
#define XB_XSUB(j)  (1280 + 64 * (j))
#define XB_XGEN(j)  (2304 + 64 * (j))
#define XB_TOP      3328
#define XB_TOPGEN   3392
#define XCD_BAR_WORDS 3456
#define XB_SPIN_CAP (1u << 18)

__device__ __forceinline__ unsigned xb_ld(unsigned* p)              { return __hip_atomic_load(p, __ATOMIC_RELAXED, __HIP_MEMORY_SCOPE_AGENT); }
__device__ __forceinline__ unsigned xb_add(unsigned* p, unsigned v) { return __hip_atomic_fetch_add(p, v, __ATOMIC_RELAXED, __HIP_MEMORY_SCOPE_AGENT); }
__device__ __forceinline__ unsigned xb_xcc_id() { return (unsigned)__builtin_amdgcn_s_getreg((3 << 11) | 20) & 0xFu; }
#define XB_SPIN(cond, bar) do { unsigned _sp = 0; while (cond) { __builtin_amdgcn_s_sleep(1); \
    if ((++_sp & 255u) == 0u) { if (xb_ld(&(bar)[XB_TMO])) break; if (_sp > XB_SPIN_CAP) { atomicAdd(&(bar)[XB_TMO], 1u); break; } } } } while (0)

struct XcdBarrier {
    unsigned* bar; unsigned x;
    volatile LAS unsigned* st;
};

__device__ __forceinline__ XcdBarrier xcd_barrier_post(unsigned* bar, volatile LAS unsigned* st, const bool leader  ) {
    XcdBarrier b; b.bar = bar; b.x = xb_xcc_id(); b.st = st;
    if (leader) (void)xb_add(&bar[XB_XCNT(b.x)], 1u);
    return b;
}
__device__ __forceinline__ void xcd_barrier_complete(unsigned* bar, unsigned x, unsigned& nloc, unsigned& nx) {
    const unsigned G = gridDim.x * gridDim.y * gridDim.z;
    unsigned sum, cnt, mine, sp = 0u;
    for (;;) {
        sum = 0u; cnt = 0u; mine = 0u;
#pragma unroll
        for (unsigned j = 0; j < 16; ++j) { const unsigned c = xb_ld(&bar[XB_XCNT(j)]); sum += c; cnt += (c > 0u) ? 1u : 0u; mine = (j == x) ? c : mine; }
        if (sum == G) break;
        __builtin_amdgcn_s_sleep(1);
        if ((++sp & 255u) == 0u) { if (xb_ld(&bar[XB_TMO])) break; if (sp > XB_SPIN_CAP) { atomicAdd(&bar[XB_TMO], 1u); break; } }
    }
    nloc = mine > 0u ? mine : 1u; nx = cnt > 0u ? cnt : 1u;
}

__device__ __forceinline__ void xcd_barrier(const XcdBarrier& b, const bool leader  ) {
    asm volatile("s_waitcnt vmcnt(0)" ::: "memory");
    __syncthreads();
    if (leader) {
        unsigned* bar = b.bar;
        __builtin_amdgcn_s_waitcnt(0);
        unsigned nloc = b.st[0], nx = b.st[1];
        if (nloc == 0u) { xcd_barrier_complete(bar, b.x, nloc, nx); b.st[0] = nloc; b.st[1] = nx; }
        const unsigned old = xb_add(&bar[XB_XSUB(b.x)], 1u);
        const unsigned gen = old / nloc;
        if (old + 1u == (gen + 1u) * nloc) {
            __builtin_amdgcn_fence(__ATOMIC_RELEASE, "agent");
            asm volatile("s_waitcnt vmcnt(0)" ::: "memory");
            const unsigned og = xb_add(&bar[XB_TOP], 1u);
            const unsigned tg = og / nx;
            if (og + 1u == (tg + 1u) * nx) xb_add(&bar[XB_TOPGEN], 1u);
            else XB_SPIN(xb_ld(&bar[XB_TOPGEN]) == tg, bar);
            __builtin_amdgcn_fence(__ATOMIC_ACQUIRE, "agent");
            xb_add(&bar[XB_XGEN(b.x)], 1u);
            asm volatile("s_waitcnt vmcnt(0)" ::: "memory");
        } else {
            XB_SPIN(xb_ld(&bar[XB_XGEN(b.x)]) == gen, bar);
            __builtin_amdgcn_fence(__ATOMIC_ACQUIRE, "agent");
            asm volatile("s_waitcnt vmcnt(0)" ::: "memory");
        }
    }
    __syncthreads();
}

constexpr int NWAVES = 8;
constexpr int NB = 8, SEQ = 2048, D = 1024, M = NB * SEQ, FF = 2816, NFF2 = 2 * FF, NH = 8, CW = 31;
constexpr float EPS = 1e-6f;
constexpr float LOG2E = 1.4426950408889634f;
constexpr float QSCALE = 0.125f * LOG2E;
constexpr int N_PHASES = 22;

constexpr size_t MiB = 1u << 20;
constexpr size_t WS_CTL = 0, CTL_ZERO_BYTES = 64 * 1024;
constexpr size_t WS_SSQ = 1 * MiB;
constexpr size_t CONF_W_ELEMS = (size_t)2048 * 1024 + (size_t)1024 * 1024 + (size_t)5632 * 1024 + (size_t)1024 * 2816;
constexpr size_t ATT_W_ELEMS  = (size_t)3072 * 1024 + (size_t)1024 * 1024 + (size_t)5632 * 1024 + (size_t)1024 * 2816;
constexpr size_t CW_PW1 = 0, CW_PW2 = (size_t)2048 * 1024, CW_W13 = CW_PW2 + (size_t)1024 * 1024, CW_W2 = CW_W13 + (size_t)5632 * 1024;
constexpr size_t AW_QKV = 0, AW_WO = (size_t)3072 * 1024, AW_W13 = AW_WO + (size_t)1024 * 1024, AW_W2 = AW_W13 + (size_t)5632 * 1024;
constexpr size_t WS_WC = 2 * MiB;
constexpr size_t WS_WA = WS_WC + 2 * CONF_W_ELEMS * 2;
constexpr size_t WS_XB = WS_WA + 2 * ATT_W_ELEMS * 2;
constexpr size_t WS_V  = WS_XB + 32 * MiB;
constexpr size_t WS_R  = WS_V + 32 * MiB;
constexpr size_t WS_K  = WS_WC;
constexpr size_t WS_H = WS_R, WS_G = WS_R, WS_U = WS_R + 32 * MiB, WS_QO = WS_R, WS_O0 = WS_R + 32 * MiB;
constexpr size_t WS_END = WS_R + 96 * MiB;
static_assert(WS_WA == 47 * MiB && WS_XB == 96 * MiB && WS_R == 160 * MiB && WS_END == 256 * MiB, "d_ws map");
static_assert((size_t)M * FF * 2 <= 96 * MiB && WS_K + 32 * MiB <= WS_WA, "d_ws overlays");

constexpr int RING_OFF = 0, RING_BYTES = 131072;
constexpr int LDSCTL_OFF = RING_BYTES, MISC_OFF = LDSCTL_OFF + 320;
constexpr int LDS_BYTES = 147456;

typedef float f32x16 __attribute__((ext_vector_type(16)));
typedef short s16x4 __attribute__((ext_vector_type(4)));
typedef float f32x2 __attribute__((ext_vector_type(2)));
typedef unsigned u32x2 __attribute__((ext_vector_type(2)));
typedef unsigned u32x4 __attribute__((ext_vector_type(4)));

struct Args { const float* in[26]; float* out; unsigned char* ws; int ph_lo, ph_hi; float lam_init2, lam_init3; };
struct Frame {
    LAS unsigned char* lds; volatile LAS unsigned* MISC; gu32* ctl;
    int tid, lane, wave, vcu, G;
};
template <int MSK> __device__ __forceinline__ float shx(float v) { return __int_as_float(__builtin_amdgcn_ds_swizzle(__float_as_int(v), (MSK << 10) | 0x1f)); }
__device__ __forceinline__ float half_sum(float v) { auto rr = __builtin_amdgcn_permlane32_swap(__float_as_uint(v), __float_as_uint(v), false, false); return __uint_as_float(rr[0]) + __uint_as_float(rr[1]); }
__device__ __forceinline__ float half_max(float v) { auto rr = __builtin_amdgcn_permlane32_swap(__float_as_uint(v), __float_as_uint(v), false, false); return fmaxf(__uint_as_float(rr[0]), __uint_as_float(rr[1])); }
__device__ __forceinline__ float half_other(float v, bool up) { auto rr = __builtin_amdgcn_permlane32_swap(__float_as_uint(v), __float_as_uint(v), false, false); return __uint_as_float(up ? rr[0] : rr[1]); }
__device__ __forceinline__ float wave_sum(float v) {
    v += shx<1>(v); v += shx<2>(v); v += shx<4>(v); v += shx<8>(v); v += shx<16>(v); return half_sum(v);
}
template <int O, int N> __device__ __forceinline__ void bfly_round(float (&v)[64], int lane) {
    const bool up = (lane & O) != 0;
#pragma unroll
    for (int i = 0; i < N; ++i) { const float send = up ? v[i] : v[i + N]; const float keep = up ? v[i + N] : v[i]; const float got = (O == 32) ? half_other(send, up) : shx<(O == 32 ? 1 : O)>(send); v[i] = keep + got; }
}
__device__ __forceinline__ int fresh_lane() { unsigned m = ~0u; asm volatile("" : "+s"(m)); int l = (int)__builtin_amdgcn_mbcnt_hi(m, __builtin_amdgcn_mbcnt_lo(m, 0u)); asm volatile("" : "+v"(l)); return l; }
__device__ __forceinline__ void refresh(Frame& F) { F.lane = fresh_lane(); F.tid = (F.wave << 6) | F.lane; }
__device__ __forceinline__ float bf_lo(unsigned v) { return __uint_as_float(v << 16); }
__device__ __forceinline__ float bf_hi(unsigned v) { return __uint_as_float(v & 0xffff0000u); }

__device__ __forceinline__ void p0_transpose_item(const float* W, int ld, int K, int nblk, const float* gain, bf16* WT, int ilv, int row_off, LAS float* scr, int item, int lane) {
    const int kb = item / nblk, nb = item % nblk, k0 = 64 * kb, n0 = 32 * nb;
    const GAS float* src = (const GAS float*)W + (size_t)(k0 + (lane >> 5)) * ld + n0 + (lane & 31);
    float v[32];
#pragma unroll
    for (int i = 0; i < 32; ++i) v[i] = src[(size_t)(2 * i) * ld];
    const int c = lane & 7;
    f32x4 g0 = (f32x4){1.f, 1.f, 1.f, 1.f}, g1 = g0;
    if (gain) { g0 = *(const GAS f32x4*)(gain + k0 + 8 * c); g1 = *(const GAS f32x4*)(gain + k0 + 8 * c + 4); }
#pragma unroll
    for (int i = 0; i < 32; ++i) scr[(2 * i + (lane >> 5)) * 33 + (lane & 31)] = v[i];
    LDS_WAIT(); asm volatile("" ::: "memory");
    const int d0 = (ilv ? (((n0 >> 7) << 8) + (n0 & 127)) : n0) + row_off;
#pragma unroll
    for (int j = 0; j < 4; ++j) { const int n = (lane >> 3) + 8 * j; const LAS float* s = scr + (8 * c) * 33 + n;
        v4u o; o.x = pk2(s[0 * 33] * g0[0], s[1 * 33] * g0[1]); o.y = pk2(s[2 * 33] * g0[2], s[3 * 33] * g0[3]); o.z = pk2(s[4 * 33] * g1[0], s[5 * 33] * g1[1]); o.w = pk2(s[6 * 33] * g1[2], s[7 * 33] * g1[3]);
        *(GAS v4u*)(WT + (size_t)(d0 + n) * K + k0 + 8 * c) = o; }
    LDS_WAIT(); asm volatile("" ::: "memory");
}
__device__ __forceinline__ void convert_layer(Frame& F, const Args& A, const int Lc, const int gw, const int NGW) {
    LAS float* scr = (LAS float*)(F.lds + RING_OFF + F.wave * 16384);
    bf16* wsb = (bf16*)A.ws;
    for (int it0 = gw; it0 < 6272; it0 += NGW) {
        const int it = __builtin_amdgcn_readfirstlane(it0);
        const int L = Lc; int r = it; int slot;
        if (r < 2048) { slot = r >> 9; r &= 511; } else { r -= 2048; slot = 4 + r / 1408; r %= 1408; }
        const float* W; int ld, K, nblk, ilv = 0, row_off = 0; const float* gain = nullptr; bf16* dst;
        bf16* wl = (L < 2) ? wsb + WS_WC / 2 + (size_t)L * CONF_W_ELEMS : wsb + WS_WA / 2 + (size_t)(L - 2) * ATT_W_ELEMS;
        if (slot >= 4) {
            if (slot == 6) { W = A.in[24] + (size_t)L * FF * D; ld = D; K = FF; nblk = D / 32; dst = wl + (L < 2 ? CW_W2 : AW_W2); }
            else { W = (slot == 4 ? A.in[22] : A.in[23]) + (size_t)L * D * FF; ld = FF; K = D; nblk = FF / 32; ilv = 1; row_off = (slot == 4) ? 0 : 128; gain = A.in[21] + L * D; dst = wl + (L < 2 ? CW_W13 : AW_W13); }
        } else if (L < 2) {
            if (slot == 3) continue;
            if (slot == 2) { W = A.in[8] + (size_t)L * D * D; ld = D; K = D; nblk = D / 32; dst = wl + CW_PW2; }
            else { W = A.in[2] + (size_t)L * D * 2 * D + (slot == 1 ? D : 0); ld = 2 * D; K = D; nblk = D / 32; ilv = 1; row_off = (slot == 1) ? 128 : 0; gain = A.in[1] + L * D; dst = wl + CW_PW1; }
        } else {
            const int j = L - 2;
            if (slot == 0) { W = A.in[14] + (size_t)j * D * D; gain = A.in[13] + j * D; dst = wl + AW_QKV; }
            else if (slot == 1) { if (j) continue; W = A.in[11]; gain = A.in[10]; dst = wl + AW_QKV; row_off = 1024; }
            else if (slot == 2) { if (j) continue; W = A.in[12]; gain = A.in[10]; dst = wl + AW_QKV; row_off = 2048; }
            else { W = A.in[20] + (size_t)j * D * D; dst = wl + AW_WO; }
            ld = D; K = D; nblk = D / 32;
        }
        p0_transpose_item(W, ld, K, nblk, gain, dst, ilv, row_off, scr, r, F.lane);
    }
}
__device__ __forceinline__ void p0_prologue(Frame& F, const Args& A) {
    refresh(F);
    const int gw = F.vcu * NWAVES + F.wave, NGW = F.G * NWAVES;
    convert_layer(F, A, 0, gw, NGW);
    const float* x = A.in[0]; bf16* XB = (bf16*)(A.ws + WS_XB); float* ssq = (float*)(A.ws + WS_SSQ);
    for (int m0 = gw * 4; m0 < M; m0 += NGW * 4) {
        f32x4 v[4][4];
#pragma unroll
        for (int q = 0; q < 4; ++q)
#pragma unroll
            for (int j = 0; j < 4; ++j) v[q][j] = *((const GAS f32x4*)(x + (size_t)(m0 + q) * D) + F.lane + 64 * j);
#pragma unroll
        for (int q = 0; q < 4; ++q) { float s = 0.f;
#pragma unroll
            for (int j = 0; j < 4; ++j) s += (v[q][j].x * v[q][j].x + v[q][j].y * v[q][j].y) + (v[q][j].z * v[q][j].z + v[q][j].w * v[q][j].w);
            s = wave_sum(s);
            GAS unsigned long long* o8 = (GAS unsigned long long*)(XB + (size_t)(m0 + q) * D) + F.lane;
#pragma unroll
            for (int j = 0; j < 4; ++j) o8[64 * j] = (unsigned long long)pk2(v[q][j].x, v[q][j].y) | ((unsigned long long)pk2(v[q][j].z, v[q][j].w) << 32);
            if (F.lane == 0) *(GAS f32x4*)(ssq + (size_t)(m0 + q) * 4) = (f32x4){s, 0.f, 0.f, 0.f}; }
    }
}
__device__ __forceinline__ void final_phase(Frame& F, float* X, const float* g) {
    refresh(F);
    const int gw = F.vcu * NWAVES + F.wave, NGW = F.G * NWAVES;
    f32x4 gv[4];
#pragma unroll
    for (int j = 0; j < 4; ++j) gv[j] = *((const GAS f32x4*)g + F.lane + 64 * j);
    for (int m0 = gw * 4; m0 < M; m0 += NGW * 4) {
        f32x4 v[4][4];
#pragma unroll
        for (int q = 0; q < 4; ++q)
#pragma unroll
            for (int j = 0; j < 4; ++j) v[q][j] = *((const GAS f32x4*)(X + (size_t)(m0 + q) * D) + F.lane + 64 * j);
#pragma unroll
        for (int q = 0; q < 4; ++q) { float s = 0.f;
#pragma unroll
            for (int j = 0; j < 4; ++j) s += (v[q][j].x * v[q][j].x + v[q][j].y * v[q][j].y) + (v[q][j].z * v[q][j].z + v[q][j].w * v[q][j].w);
            const float rs = 1.0f / sqrtf(wave_sum(s) * (1.0f / D) + EPS);
#pragma unroll
            for (int j = 0; j < 4; ++j) *((GAS f32x4*)(X + (size_t)(m0 + q) * D) + F.lane + 64 * j) = v[q][j] * rs * gv[j]; }
    }
}
__device__ __forceinline__ void conv_phase(Frame& F, const bf16* G, bf16* U, const float* dww, const float* dwb, const float* lng, const float* lnb) {
    refresh(F);
    LAS float* red = (LAS float*)(F.lds + RING_OFF);
    for (int unit = F.vcu; unit < M / 32; unit += F.G) {
        int c0 = 2 * F.tid; asm volatile("" : "+v"(c0));
        f32x2 w[CW];
#pragma unroll
        for (int j = 0; j < CW; ++j) w[j] = *(const GAS f32x2*)(dww + j * D + c0);
        const int row0 = unit * 32; const bool head = ((row0 & (SEQ - 1)) == 0);
        f32x2 acc[32];
#pragma unroll
        for (int p = 0; p < 32; ++p) acc[p] = (f32x2){0.f, 0.f};
        unsigned gin[62];
        { const GAS unsigned* gp = (const GAS unsigned*)(G + (size_t)(head ? row0 : row0 - 30) * D + c0);
#pragma unroll
          for (int i = 0; i < 62; ++i) gin[i] = gp[(size_t)(head ? (i < 30 ? 0 : i - 30) : i) * (D / 2)]; }
        const float hmsk = head ? 0.0f : 1.0f;
#pragma unroll
        for (int i = 0; i < 62; ++i) {
            const float msk = (i < 30) ? hmsk : 1.0f;
            const unsigned v = gin[i];
            const f32x2 g = (f32x2){bf_lo(v) * msk, bf_hi(v) * msk};
#pragma unroll
            for (int p = (i > 30 ? i - 30 : 0); p <= (i < 31 ? i : 31); ++p) acc[p] += w[i - p] * g;
        }
        float v[64];
        const f32x2 bb = *(const GAS f32x2*)(dwb + c0), gg = *(const GAS f32x2*)(lng + c0), be = *(const GAS f32x2*)(lnb + c0);
#pragma unroll
        for (int p = 0; p < 32; ++p) { acc[p] += bb; v[p] = acc[p].x + acc[p].y; v[32 + p] = acc[p].x * acc[p].x + acc[p].y * acc[p].y; }
        bfly_round<32, 32>(v, F.lane); bfly_round<16, 16>(v, F.lane); bfly_round<8, 8>(v, F.lane); bfly_round<4, 4>(v, F.lane); bfly_round<2, 2>(v, F.lane); bfly_round<1, 1>(v, F.lane);
        __syncthreads();
        red[F.wave * 64 + F.lane] = v[0];
        __syncthreads();
        if (F.tid < 64) { float t = 0.f;
#pragma unroll
            for (int wv = 0; wv < 8; ++wv) t += red[wv * 64 + F.tid];
            red[512 + F.tid] = t; }
        __syncthreads();
#pragma unroll
        for (int p = 0; p < 32; ++p) {
            const float mean = red[512 + p] * (1.0f / D), var = red[512 + 32 + p] * (1.0f / D) - mean * mean, rs = 1.0f / sqrtf(fmaxf(var, 0.f) + EPS);
            const f32x2 y = (acc[p] - mean) * rs * gg + be;
            const float s0 = y.x * pg8::sigmoidf_(y.x), s1 = y.y * pg8::sigmoidf_(y.y);
            *(GAS unsigned*)(U + (size_t)(row0 + p) * D + c0) = pk2(s0, s1);
        }
    }
}
__device__ __forceinline__ int crow(int r, int hi) { return (r & 3) + 8 * (r >> 2) + 4 * hi; }
constexpr int AK_SLOT = 8192, AV_SLOT = 16384, A_KRING = 0, A_VRING = 3 * AK_SLOT, A_WSF = A_VRING + 3 * AV_SLOT;
constexpr float ATT_THR = 8.0f;
#define SBAR() __builtin_amdgcn_sched_barrier(0)
#if (PROBE_REP >> 8) & 1
#define ATT_WAIT_BAR_N(N) ATT_WAIT_BAR2(N)
#define ATT_WAIT_BAR2(N) do { if (N == 3) ATT_WAIT_BAR(6); else ATT_WAIT_BAR(4); } while (0)
#else
#define ATT_WAIT_BAR_N(N) ATT_WAIT_BAR(N)
#endif
#define ATT_WAIT_BAR(N) asm volatile("s_waitcnt vmcnt(" #N ") lgkmcnt(0)\n\ts_barrier" ::: "memory")
__device__ __forceinline__ void glds16s(const void* sbase, unsigned voff, unsigned lds_dst) {
    unsigned keep; asm volatile("s_mov_b32 %0, m0\n\ts_mov_b32 m0, %2\n\ts_nop 0\n\tglobal_load_lds_dwordx4 %1, %3\n\ts_mov_b32 m0, %0" : "=&s"(keep) : "v"(voff), "s"(lds_dst), "s"(sbase) : "memory"); }
__device__ __forceinline__ float att_rowmax(const f32x16& p0, const f32x16& p1) {
    float a = fmaxf(fmaxf(p0[0], p0[1]), p1[0]), b = fmaxf(fmaxf(p0[2], p0[3]), p1[1]); a = fmaxf(fmaxf(a, p1[2]), p1[3]);
#pragma unroll
    for (int r = 4; r < 16; r += 4) { a = fmaxf(fmaxf(a, p0[r]), p0[r + 1]); b = fmaxf(fmaxf(b, p0[r + 2]), p0[r + 3]); a = fmaxf(fmaxf(a, p1[r]), p1[r + 1]); b = fmaxf(fmaxf(b, p1[r + 2]), p1[r + 3]); }
    return half_max(fmaxf(a, b));
}
__device__ __forceinline__ void att_mask(f32x16& p0, f32x16& p1, int kb, int tq) {
#pragma unroll
    for (int r = 0; r < 16; ++r) { const int kv = kb + (r & 3) + 8 * (r >> 2); if (kv > tq) p0[r] = -INFINITY; if (kv + 32 > tq) p1[r] = -INFINITY; }
}
__device__ __forceinline__ void att_qk(f32x16& p0, f32x16& p1, const LAS unsigned char* kp, const bf16x8 (&qr)[4], const f32x16& cin) {
    bf16x8 kf[8];
#pragma unroll
    for (int d0 = 0; d0 < 4; ++d0) { kf[2 * d0] = *(const LAS bf16x8*)(kp + d0 * 2048); kf[2 * d0 + 1] = *(const LAS bf16x8*)(kp + d0 * 2048 + 512); }
    SBAR();
#pragma unroll
    for (int d0 = 0; d0 < 4; ++d0) {
        p0 = __builtin_amdgcn_mfma_f32_32x32x16_bf16(kf[2 * d0], qr[d0], d0 == 0 ? cin : p0, 0, 0, 0); p1 = __builtin_amdgcn_mfma_f32_32x32x16_bf16(kf[2 * d0 + 1], qr[d0], d0 == 0 ? cin : p1, 0, 0, 0); }
}
__device__ __forceinline__ void att_pv(f32x16 (&o)[4], const LAS unsigned char* vp, const u32x4 (&pw)[4]) {
#pragma unroll
    for (int d0 = 0; d0 < 4; ++d0)
#pragma unroll
        for (int ks = 0; ks < 4; ++ks) {
            const s16x4 lo = __builtin_bit_cast(s16x4, __builtin_amdgcn_ds_read_tr16_b64_v4i16((LAS s16x4*)(vp + d0 * 4096 + ks * 1024)));
            const s16x4 hh = __builtin_bit_cast(s16x4, __builtin_amdgcn_ds_read_tr16_b64_v4i16((LAS s16x4*)(vp + d0 * 4096 + ks * 1024 + 512)));
            const bf16x8 vf = (bf16x8){lo[0], lo[1], lo[2], lo[3], hh[0], hh[1], hh[2], hh[3]};
            o[d0] = __builtin_amdgcn_mfma_f32_32x32x16_bf16(__builtin_bit_cast(bf16x8, pw[ks]), vf, o[d0], 0, 0, 0); }
}
typedef __bf16 bf16x2_t __attribute__((ext_vector_type(2)));
__device__ __forceinline__ unsigned cvtpk_s(float lo, float hi) { f32x2 v = {lo, hi}; return __builtin_bit_cast(unsigned, __builtin_convertvector(v, bf16x2_t)); }
__device__ __forceinline__ void att_mask_arith(f32x16& p0, f32x16& p1, int kb, int tq) {
    const float x = (float)(kb - tq);
#pragma unroll
    for (int r = 0; r < 16; ++r) { const float kr = (float)((r & 3) + 8 * (r >> 2));
        p0[r] = __builtin_fmaf(fmaxf(x + kr, 0.f), -1e30f, p0[r]); p1[r] = __builtin_fmaf(fmaxf(x + (kr + 32.0f), 0.f), -1e30f, p1[r]); }
}
__device__ __forceinline__ s16x4 att_vtr(const LAS unsigned char* p) { return __builtin_bit_cast(s16x4, __builtin_amdgcn_ds_read_tr16_b64_v4i16((LAS s16x4*)p)); }
template <bool DOEXP> __device__ __forceinline__ float att_pv_exp(f32x16 (&o)[4], const LAS unsigned char* vp, const u32x4 (&pwi)[4], f32x16& p0, f32x16& p1, u32x4 (&pwo)[4]) {
    s16x4 vl[8], vh[8]; float ls = 0.f;
#define VRD(i) do { vl[(i) & 7] = att_vtr(vp + ((i) & 3) * 4096 + ((i) >> 2) * 1024); vh[(i) & 7] = att_vtr(vp + ((i) & 3) * 4096 + ((i) >> 2) * 1024 + 512); } while (0)
#define VFR(i) (bf16x8){vl[(i) & 7][0], vl[(i) & 7][1], vl[(i) & 7][2], vl[(i) & 7][3], vh[(i) & 7][0], vh[(i) & 7][1], vh[(i) & 7][2], vh[(i) & 7][3]}
#ifndef ATT_PF
#define ATT_PF 4
#endif
#pragma unroll
    for (int i = 0; i < ATT_PF; ++i) VRD(i);
    SBAR();
#pragma unroll
    for (int i = 0; i < 16; ++i) {
        o[i & 3] = __builtin_amdgcn_mfma_f32_32x32x16_bf16(__builtin_bit_cast(bf16x8, pwi[i >> 2]), VFR(i), o[i & 3], 0, 0, 0);
        if (i + ATT_PF < 16) VRD(i + ATT_PF);
        if (DOEXP) { float e0, e1;
            if (i < 8) { e0 = __builtin_amdgcn_exp2f(p0[2 * i]); e1 = __builtin_amdgcn_exp2f(p0[2 * i + 1]); } else { e0 = __builtin_amdgcn_exp2f(p1[2 * i - 16]); e1 = __builtin_amdgcn_exp2f(p1[2 * i - 15]); }
#if (PROBE_REP >> 9) & 1
            { float x0 = (i < 8) ? p0[2 * i] : p1[2 * i - 16], x1 = (i < 8) ? p0[2 * i + 1] : p1[2 * i - 15]; asm volatile("" : "+v"(x0), "+v"(x1)); float d0_ = __builtin_amdgcn_exp2f(x0), d1_ = __builtin_amdgcn_exp2f(x1); float s_ = d0_ + d1_; unsigned c_ = cvtpk_s(d0_, d1_); asm volatile("" :: "v"(s_), "v"(c_)); }
#endif
            ls += e0; ls += e1; pwo[i >> 2][i & 3] = cvtpk_s(e0, e1);
            asm volatile("" : "+v"(ls), "+v"(pwo[i >> 2][i & 3])); }
        SBAR();
    }
#undef VRD
#undef VFR
    return ls;
}
__device__ __forceinline__ void attn_unit(Frame& F, int b, int h, int qb, const bf16* Qb, const bf16* Kb, const bf16* Vb, bf16* Ob, float* O0, float lam, float lam_init, const float* subg, const bool do_store = true) {
    const int lane = F.lane, r32 = lane & 31, hi = lane >> 5, wid = F.wave;
    LAS unsigned char* lds = F.lds + RING_OFF;
    const unsigned lds0 = (unsigned)(uintptr_t)lds;
    LAS float* wsf = (LAS float*)(lds + A_WSF) + wid * 64;
    const size_t rowbase = (size_t)b * SEQ; const int q0 = qb * 256, NT = 4 * (qb + 1);
    const int tq = q0 + 32 * wid + r32;
    const float sl2 = LOG2E * __builtin_amdgcn_exp2f(-(float)(h + 1));
    const int unit_lin = (b * NH + h) * 8 + qb;
    const LAS unsigned char* kp0 = lds + A_KRING + hi * 1024 + r32 * 16;
    const LAS unsigned char* vp0 = lds + A_VRING + ((lane >> 4) & 1) * 32 + (lane & 3) * 8 + (4 * hi + ((lane & 15) >> 2)) * 64;
    const unsigned kdst = lds0 + A_KRING + wid * 1024, vdst = lds0 + A_VRING + wid * 1024;
    const int wdiag = wid >> 1;
#pragma unroll 1
    for (int c = 0; c < 2; ++c) {
        const bf16* Qw = Qb + (rowbase + q0 + wid * 32) * D + (2 * h + c) * 64;
        const bf16* kbase = Kb + rowbase * D + (2 * h + c) * 64 + wid * 8;
        const bf16* vbase = Vb + (rowbase + 16 * (wid & 3)) * D + h * 128 + (wid >> 2) * 32;
        const unsigned kvoff = (unsigned)lane * (D * 2), vvoff = (unsigned)(lane >> 2) * (D * 2) + (unsigned)(lane & 3) * 16;
#if (PROBE_REP >> 8) & 1
#define DMA_K(t, slot) do { glds16s(kbase + (size_t)(t) * 64 * D, kvoff, (unsigned)__builtin_amdgcn_readfirstlane(kdst + (slot) * AK_SLOT)); glds16s(kbase + (size_t)(t) * 64 * D, kvoff, (unsigned)__builtin_amdgcn_readfirstlane(kdst + (slot) * AK_SLOT)); } while (0)
#else
#define DMA_K(t, slot) glds16s(kbase + (size_t)(t) * 64 * D, kvoff, (unsigned)__builtin_amdgcn_readfirstlane(kdst + (slot) * AK_SLOT))
#endif
#if (PROBE_REP >> 8) & 1
#define DMA_V(t, slot) do { glds16s(vbase + (size_t)(t) * 64 * D, vvoff, (unsigned)__builtin_amdgcn_readfirstlane(vdst + (slot) * AV_SLOT)); \
                            glds16s(vbase + 64 + (size_t)(t) * 64 * D, vvoff, (unsigned)__builtin_amdgcn_readfirstlane(vdst + (slot) * AV_SLOT + 8192)); \
                            glds16s(vbase + (size_t)(t) * 64 * D, vvoff, (unsigned)__builtin_amdgcn_readfirstlane(vdst + (slot) * AV_SLOT)); \
                            glds16s(vbase + 64 + (size_t)(t) * 64 * D, vvoff, (unsigned)__builtin_amdgcn_readfirstlane(vdst + (slot) * AV_SLOT + 8192)); } while (0)
#else
#define DMA_V(t, slot) do { glds16s(vbase + (size_t)(t) * 64 * D, vvoff, (unsigned)__builtin_amdgcn_readfirstlane(vdst + (slot) * AV_SLOT)); \
                            glds16s(vbase + 64 + (size_t)(t) * 64 * D, vvoff, (unsigned)__builtin_amdgcn_readfirstlane(vdst + (slot) * AV_SLOT + 8192)); } while (0)
#endif
        DMA_K(0, 0); DMA_V(0, 0); DMA_K(1, 1);
        bf16x8 qr[4];
#pragma unroll
        for (int d0 = 0; d0 < 4; ++d0) qr[d0] = *(const GAS bf16x8*)(Qw + (size_t)r32 * D + d0 * 16 + hi * 8);
        f32x16 o[4];
#pragma unroll
        for (int d0 = 0; d0 < 4; ++d0) o[d0] = (f32x16){};
        float mref, l_run = 0.f; u32x4 pwA[4], pwB[4]; f32x16 p0, p1;
        ATT_WAIT_BAR_N(3);
        DMA_K(2, 2); DMA_V(1, 1);
        {
            const f32x16 z = (f32x16){};
            att_qk(p0, p1, kp0, qr, z);
            if (NT == 4 && wdiag == 0) att_mask_arith(p0, p1, 4 * hi, tq);
            mref = att_rowmax(p0, p1);
            const float cb = sl2 * (float)(4 * hi - tq) - mref;
#pragma unroll
            for (int r = 0; r < 16; ++r) { const float kr = (float)((r & 3) + 8 * (r >> 2)); p0[r] = __builtin_fmaf(sl2, kr, p0[r]) + cb; p1[r] = __builtin_fmaf(sl2, kr + 32.0f, p1[r]) + cb; }
#pragma unroll
            for (int i = 0; i < 16; ++i) { float e0, e1;
                if (i < 8) { e0 = __builtin_amdgcn_exp2f(p0[2 * i]); e1 = __builtin_amdgcn_exp2f(p0[2 * i + 1]); } else { e0 = __builtin_amdgcn_exp2f(p1[2 * i - 16]); e1 = __builtin_amdgcn_exp2f(p1[2 * i - 15]); }
                l_run += e0; l_run += e1; pwA[i >> 2][i & 3] = cvtpk_s(e0, e1); }
        }
        ATT_WAIT_BAR_N(3);
        int sp = 2, sc = 0, sn = 1;
#define ATT_STEP(t, PWI, PWO) do { \
            sp = sc; sc = sn; sn = (sn == 2) ? 0 : sn + 1; \
            if ((t) + 2 < NT) DMA_K((t) + 2, sp); \
            if ((t) + 1 < NT) DMA_V((t) + 1, sn); \
            { const float cv = sl2 * (float)(64 * (t) + 4 * hi - tq) - mref; f32x16 cin; \
              _Pragma("unroll") for (int r = 0; r < 16; ++r) cin[r] = cv; \
              att_qk(p0, p1, kp0 + sc * AK_SLOT, qr, cin); } \
            _Pragma("unroll") for (int r = 0; r < 16; ++r) { const float kr = (float)((r & 3) + 8 * (r >> 2)); p0[r] = __builtin_fmaf(sl2, kr, p0[r]); p1[r] = __builtin_fmaf(sl2, kr + 32.0f, p1[r]); } \
            if ((t) >= NT - 4 && (t) - (NT - 4) >= wdiag) att_mask_arith(p0, p1, 64 * (t) + 4 * hi, tq); \
            const float rm = att_rowmax(p0, p1); \
            if (__builtin_expect(__any(rm > ATT_THR), 0)) { \
                const float dl = fmaxf(rm, 0.f), fs = __builtin_amdgcn_exp2f(-dl); mref += dl; l_run *= fs; \
                _Pragma("unroll") for (int r = 0; r < 16; ++r) { p0[r] -= dl; p1[r] -= dl; } \
                _Pragma("unroll") for (int ks = 0; ks < 4; ++ks) _Pragma("unroll") for (int k = 0; k < 4; ++k) { const unsigned wv = PWI[ks][k]; PWI[ks][k] = cvtpk_s(bf_lo(wv) * fs, bf_hi(wv) * fs); } \
                if (hi == 0) wsf[r32] = fs; \
                _Pragma("unroll") for (int r = 0; r < 16; ++r) { const float fr_ = wsf[crow(r, hi)]; _Pragma("unroll") for (int d0 = 0; d0 < 4; ++d0) o[d0][r] *= fr_; } \
            } \
            SBAR(); \
            l_run += att_pv_exp<true>(o, vp0 + sp * AV_SLOT, PWI, p0, p1, PWO); \
            if ((t) + 2 < NT) ATT_WAIT_BAR_N(3); else if ((t) + 1 < NT) ATT_WAIT_BAR_N(2); else ATT_WAIT_BAR(0); \
        } while (0)
        int t = 1;
#pragma unroll 1
        for (; t + 1 < NT; t += 2) { ATT_STEP(t, pwA, pwB); ATT_STEP(t + 1, pwB, pwA); }
        ATT_STEP(t, pwA, pwB);
#undef ATT_STEP
        (void)att_pv_exp<false>(o, vp0 + sc * AV_SLOT, pwB, p0, p1, pwA);
        asm volatile("s_waitcnt lgkmcnt(0)\n\ts_barrier" ::: "memory");
#undef DMA_K
#undef DMA_V
        l_run = half_sum(l_run);
        if (hi == 0) wsf[32 + r32] = l_run;
        float rl[16];
#pragma unroll
        for (int r = 0; r < 16; ++r) rl[r] = 1.0f / wsf[32 + crow(r, hi)];
        int ln_ = lane; asm volatile("" : "+v"(ln_));
        float* park = O0 + ((size_t)(unit_lin * 8 + wid) * 64 + ln_) * 64;
        if (c == 0) {
#pragma unroll
            for (int d0 = 0; d0 < 4; ++d0)
#pragma unroll
                for (int q = 0; q < 4; ++q) *(GAS f32x4*)(park + d0 * 16 + q * 4) = (f32x4){o[d0][4 * q] * rl[4 * q], o[d0][4 * q + 1] * rl[4 * q + 1], o[d0][4 * q + 2] * rl[4 * q + 2], o[d0][4 * q + 3] * rl[4 * q + 3]};
        } else {
            asm volatile("s_waitcnt vmcnt(0)" ::: "memory");
            float ss[16];
#pragma unroll
            for (int r = 0; r < 16; ++r) ss[r] = 0.f;
#pragma unroll
            for (int d0 = 0; d0 < 4; ++d0)
#pragma unroll
                for (int q = 0; q < 4; ++q) { const f32x4 pk = *(const GAS f32x4*)(park + d0 * 16 + q * 4);
#pragma unroll
                    for (int i = 0; i < 4; ++i) { const int r = 4 * q + i; const float v = pk[i] - lam * (o[d0][r] * rl[r]); o[d0][r] = v; ss[r] += v * v; } }
#pragma unroll
            for (int r = 0; r < 16; ++r) {
                ss[r] += shx<1>(ss[r]); ss[r] += shx<2>(ss[r]); ss[r] += shx<4>(ss[r]); ss[r] += shx<8>(ss[r]); ss[r] += shx<16>(ss[r]);
                ss[r] = (1.0f - lam_init) / sqrtf(ss[r] * (1.0f / 128.0f) + EPS); }
            float gsub[4];
#pragma unroll
            for (int d0 = 0; d0 < 4; ++d0) gsub[d0] = subg[32 * d0 + r32];
            bf16* Ow = Ob + (rowbase + q0 + wid * 32 + 4 * hi + 2) * D + h * 128 + r32;
            if (do_store)
#pragma unroll
            for (int g = 0; g < 4; ++g) { asm volatile("" : "+v"(Ow));
#pragma unroll
                for (int i = 0; i < 4; ++i)
#pragma unroll
                    for (int d0 = 0; d0 < 4; ++d0) Ow[(i - 2) * D + 32 * d0] = (bf16)f2bf(o[d0][4 * g + i] * ss[4 * g + i] * gsub[d0]);
                Ow += 8 * D; }
        }
        __syncthreads();
    }
}
__device__ __forceinline__ void attn_phase(Frame& F, const Args& A, int j, float lam_init) {
    refresh(F);
    const bf16* Qb = (const bf16*)(A.ws + WS_QO); const bf16* Kb = (const bf16*)(A.ws + WS_K); const bf16* Vb = (const bf16*)(A.ws + WS_V);
    bf16* Ob = (bf16*)(A.ws + WS_QO); float* O0 = (float*)(A.ws + WS_O0);
    const float a = wave_sum(A.in[15][j * 64 + F.lane] * A.in[16][j * 64 + F.lane]), b2 = wave_sum(A.in[17][j * 64 + F.lane] * A.in[18][j * 64 + F.lane]);
    const float lam = expf(a) - expf(b2) + lam_init;
    const float* subg = A.in[19] + j * 128;
    for (int w = 2 * F.vcu; w < NB * NH * 8; w += 2 * F.G) {
#pragma unroll 1
        for (int e = 0; e < 2; ++e) { const int ww = w + e, bh = ww >> 3, k = ww & 7, qb = (k & 1) ? 7 - (k >> 1) : (k >> 1);
#if (PROBE_REP >> 4) & 1
            attn_unit(F, bh >> 3, bh & 7, qb, Qb, Kb, Vb, Ob, O0, lam, lam_init, subg, false);
#endif
            attn_unit(F, bh >> 3, bh & 7, qb, Qb, Kb, Vb, Ob, O0, lam, lam_init, subg); }
    }
}

__global__ void __launch_bounds__(NWAVES * 64, 2) yoco_fwd(Args args) {
    extern __shared__ __attribute__((aligned(16))) unsigned char lds_raw[];
    Frame F;
    F.lds = (LAS unsigned char*)lds_raw;
    F.MISC = (volatile LAS unsigned*)(F.lds + MISC_OFF);
    F.tid = threadIdx.x; F.lane = F.tid & 63; F.wave = __builtin_amdgcn_readfirstlane(F.tid >> 6);
    F.G = gridDim.x; { const int bx = blockIdx.x; F.vcu = (F.G % 8 == 0) ? (bx % 8) * (F.G / 8) + bx / 8 : bx; }
    unsigned char* ws = args.ws;
    F.ctl = (gu32*)(ws + WS_CTL);
    for (int u = F.tid; u < (LDS_BYTES - LDSCTL_OFF) / 4; u += NWAVES * 64) ((LAS unsigned*)(F.lds + LDSCTL_OFF))[u] = 0u;
    __syncthreads();
    const int lo = args.ph_lo, hi = args.ph_hi;
    XcdBarrier bar; bar.bar = (unsigned*)F.ctl; bar.x = 0; bar.st = nullptr;
    if (hi - lo > 1) bar = xcd_barrier_post((unsigned*)F.ctl, F.MISC + 8, F.tid == 0);

    bf16* wsb = (bf16*)ws;
    bf16* XB = (bf16*)(ws + WS_XB); float* SSQ = (float*)(ws + WS_SSQ); float* X = args.out;
#pragma unroll 1
    for (int ph = lo; ph < hi; ++ph) {
#if PROBE_REP
      int kind_ = 0; if (ph == 0) kind_ = 0; else if (ph == N_PHASES - 1) kind_ = 15; else { const int L_ = (ph - 1) / 5, k_ = (ph - 1) % 5; kind_ = (k_ == 0) ? (L_ < 2 ? 1 : 3) : (k_ == 1) ? (L_ < 2 ? 2 : 4) : (k_ == 3) ? 5 : 15; }
      const int reps_ = 1 + ((kind_ != 4) && ((PROBE_REP >> kind_) & 1));
#pragma unroll 1
      for (int rep_ = 0; rep_ < reps_; ++rep_) {
        if (rep_) xcd_barrier(bar, F.wave == 0 && fresh_lane() == 0);
#endif
        if (ph == 0) p0_prologue(F, args);
        else if (ph == N_PHASES - 1) final_phase(F, X, args.in[25]);
        else {
            const int L = (ph - 1) / 5, k = (ph - 1) % 5;
            bf16* wl = (L < 2) ? wsb + WS_WC / 2 + (size_t)L * CONF_W_ELEMS : wsb + WS_WA / 2 + (size_t)(L - 2) * ATT_W_ELEMS;
            if (k == 0 && L < 2) {
                pg8::Gemm g{XB, wl + CW_PW1, M, 2 * D, D}; pg8::StaticOrder S; S.init(M, 2 * D, F.G, (int)blockIdx.x);
                pg8::EpiGate<0> E{(bf16*)(ws + WS_G), D, SSQ, args.in[3] + L * 2 * D};
                pg8::gemm_phase<pg8::EpiGate<0>, pg8::StaticOrder, true, true>(F.lds + RING_OFF, g, S, E, F.wave);
            } else if (k == 0) {
                const int N = (L == 2) ? 3 * D : D;
                pg8::Gemm g{XB, wl + AW_QKV, M, N, D}; pg8::StaticOrder S; S.init(M, N, F.G, (int)blockIdx.x);
                typedef pg8::EpiQKV<WS_QO, WS_K, WS_V> EQ; EQ E{ws, SSQ, QSCALE};
                pg8::gemm_phase<EQ, pg8::StaticOrder, true, true>(F.lds + RING_OFF, g, S, E, F.wave);
            } else if (k == 1 && L < 2) {
                conv_phase(F, (const bf16*)(ws + WS_G), (bf16*)(ws + WS_U), args.in[4] + L * CW * D, args.in[5] + L * D, args.in[6] + L * D, args.in[7] + L * D);
            } else if (k == 1) {
                attn_phase(F, args, L - 2, L == 2 ? args.lam_init2 : args.lam_init3);
            } else if (k == 3) {
                pg8::Gemm g{XB, wl + (L < 2 ? CW_W13 : AW_W13), M, NFF2, D}; pg8::StaticOrder S; S.init(M, NFF2, F.G, (int)blockIdx.x);
                pg8::EpiGate<1> E{(bf16*)(ws + WS_H), FF, SSQ, nullptr};
                pg8::gemm_phase<pg8::EpiGate<1>, pg8::StaticOrder, true, true>(F.lds + RING_OFF, g, S, E, F.wave);
                { pg8::Unit u_; const int nfull = (M / 256) * (NFF2 / 256) / F.G, nrem = (M / 256) * (NFF2 / 256) % F.G;
                  if (L < 3 && nrem && !S.next(nfull, u_)) { refresh(F); convert_layer(F, args, L + 1, ((int)blockIdx.x - nrem) * NWAVES + F.wave, (F.G - nrem) * NWAVES); }
                  else if (L < 3 && !nrem) { refresh(F); convert_layer(F, args, L + 1, F.vcu * NWAVES + F.wave, F.G * NWAVES); } }
            } else {
                const bf16* Aop; const bf16* Bop; int K; const float* bias = nullptr;
                if (k == 4) { Aop = (const bf16*)(ws + WS_H); Bop = wl + (L < 2 ? CW_W2 : AW_W2); K = FF; }
                else if (L < 2) { Aop = (const bf16*)(ws + WS_U); Bop = wl + CW_PW2; K = D; bias = args.in[9] + L * D; }
                else { Aop = (const bf16*)(ws + WS_QO); Bop = wl + AW_WO; K = D; }
                pg8::Gemm g{Aop, Bop, M, D, K}; pg8::StaticOrder S; S.init(M, D, F.G, (int)blockIdx.x);
                pg8::EpiRes E{XB, (L == 3 && k == 4) ? X : nullptr, SSQ, bias};
                if (F.G == 256) pg8::gemm_phase<pg8::EpiRes, pg8::StaticOrder, false, true>(F.lds + RING_OFF, g, S, E, F.wave);
            }
        }
#if PROBE_REP
      }
      if ((PROBE_REP >> 6) & 1) { if (ph + 1 < hi) xcd_barrier(bar, F.wave == 0 && fresh_lane() == 0); }
#endif
        if (ph + 1 < hi) xcd_barrier(bar, F.wave == 0 && fresh_lane() == 0);
    }
}

#ifndef MK_ONE_LAUNCH
#define MK_ONE_LAUNCH 0
#endif
extern "C" void kernel_launch(void* const* d_in, const int* in_sizes, int n_in, void* d_out, int out_size, void* d_ws, size_t ws_size, hipStream_t stream) {
    static int grid = 0;
    if (grid == 0) {
        if (n_in != 26 || in_sizes[0] != M * D || out_size != M * D || ws_size < WS_END) { fprintf(stderr, "kernel_launch: unexpected shapes (n_in %d, in0 %d, out %d, ws %zu); nothing launched\n", n_in, n_in > 0 ? in_sizes[0] : -1, out_size, ws_size); grid = -1; return; }
        int dev = 0, cus = 0, per_cu = 0;
        if (hipGetDevice(&dev) != hipSuccess || hipDeviceGetAttribute(&cus, hipDeviceAttributeMultiprocessorCount, dev) != hipSuccess) { grid = -1; return; }
        if (hipFuncSetAttribute((const void*)yoco_fwd, hipFuncAttributeMaxDynamicSharedMemorySize, LDS_BYTES) != hipSuccess) { fprintf(stderr, "kernel_launch: hipFuncSetAttribute failed\n"); grid = -1; return; }
        if (hipOccupancyMaxActiveBlocksPerMultiprocessor(&per_cu, (const void*)yoco_fwd, NWAVES * 64, LDS_BYTES) != hipSuccess || per_cu < 1) { fprintf(stderr, "kernel_launch: occupancy query says %d blocks per CU\n", per_cu); }
        (void)hipGetLastError();
        grid = cus;
        if (grid != 256) fprintf(stderr, "kernel_launch: %d CUs; the residual GEMM phases need exactly 256 workgroups\n", grid);
    }
    if (grid < 0) return;
    if (hipMemsetAsync((char*)d_ws + WS_CTL, 0, CTL_ZERO_BYTES, stream) != hipSuccess) return;
    Args a{};
    for (int i = 0; i < 26; ++i) a.in[i] = (const float*)d_in[i];
    a.out = (float*)d_out; a.ws = (unsigned char*)d_ws;
    a.lam_init2 = (float)(0.8 - 0.6 * exp(-0.3 * 2.0)); a.lam_init3 = (float)(0.8 - 0.6 * exp(-0.3 * 3.0));
#if MK_ONE_LAUNCH
    a.ph_lo = 0; a.ph_hi = N_PHASES;
    hipLaunchKernelGGL(yoco_fwd, dim3(grid), dim3(NWAVES * 64), LDS_BYTES, stream, a);
#else
    for (int p = 0; p < N_PHASES; ++p) { a.ph_lo = p; a.ph_hi = p + 1; hipLaunchKernelGGL(yoco_fwd, dim3(grid), dim3(NWAVES * 64), LDS_BYTES, stream, a); }
#endif
}
```

```cpp
#define MK_ONE_LAUNCH 1
#define PROBE_REP 0
#include <hip/hip_runtime.h>
#include <cstdio>
#include <cstdint>
#include <cmath>
namespace pg8 {
#define PG8_LAS __attribute__((address_space(3)))
typedef unsigned short bf16_t;
typedef short bf16x8 __attribute__((ext_vector_type(8)));
typedef float f32x4 __attribute__((ext_vector_type(4)));
typedef unsigned u32x4 __attribute__((ext_vector_type(4)));
constexpr int BM = 256, BK = 64, HALF = 128, HTB = HALF * BK * 2  , STAGE_BYTES = 8 * HTB, NXCD = 8, WGM = 8;

__host__ __device__ __forceinline__ int lds_byte(int r, int c) { const int st = (r >> 4) * 2 + (c >> 5), rr = r & 15, cc = c & 31, ob = rr * 64 + cc * 2; return st * 1024 + (ob ^ (((ob >> 9) & 1) << 5)); }
__host__ __device__ __forceinline__ void stage_rc(int b, int& R, int& C) { const int st = b / 1024, sb = b % 1024, swz = sb ^ (((sb >> 9) & 1) << 5); R = (st >> 1) * 16 + swz / 64; C = (st & 1) * 32 + (swz % 64) / 2; }
__host__ __device__ __forceinline__ int perm32(int rho) { const int n = rho >> 4, i = rho & 15; return 8 * (i >> 2) + 4 * n + (i & 3); }

struct Unit { int pm, pn, i; };
struct Gemm { const bf16_t* A; const bf16_t* Bt; int M, N, K; };

struct StaticOrder {
    int nM, nN, nwg, G, c;
    __host__ __device__ void init(int M, int N, int G_, int c_) { nM = M / BM; nN = N / BM; nwg = nM * nN; G = G_; c = c_; }
    __host__ __device__ bool next(int i, Unit& u) const {
        const long L = (long)i * G + c; if (L >= nwg) return false;
        int wgid = (int)L; { const int q = nwg / NXCD, r = nwg % NXCD, xcd = wgid % NXCD, off = wgid / NXCD; wgid = (xcd < r ? xcd * (q + 1) : r * (q + 1) + (xcd - r) * q) + off; }
        const int nig = WGM * nN, gid = wgid / nig, fm = gid * WGM, gsz = (nM - fm) < WGM ? (nM - fm) : WGM;
        u.pm = fm + ((wgid % nig) % gsz); u.pn = (wgid % nig) / gsz; u.i = i; return true;
    }
    __device__ __forceinline__ void a_ready(const Unit&) const {}
    __device__ __forceinline__ void done(const Unit&) const {}
};
constexpr int AUX_BYTES = 5120;
struct AuxOrder : StaticOrder {
    const float* ssq; const float* bias; PG8_LAS unsigned char* aux; int wid, lane;
    __device__ __forceinline__ void a_ready(const Unit& u) const {
        PG8_LAS unsigned char* dst = aux + (u.i & 1) * AUX_BYTES;
        if (wid < 4) __builtin_amdgcn_global_load_lds((const unsigned*)(ssq + ((size_t)u.pm * BM + wid * 64 + lane) * 4), (PG8_LAS unsigned*)(dst + wid * 1024), 16, 0, 0);
        else if (wid == 4 && bias) __builtin_amdgcn_global_load_lds((const unsigned*)(bias + (lane >> 5) * 1024 + u.pn * HALF + (lane & 31) * 4), (PG8_LAS unsigned*)(dst + 4096), 16, 0, 0);
    }
};

__device__ __forceinline__ unsigned cvt_pk_bf16(float lo, float hi) { unsigned r; asm volatile("v_cvt_pk_bf16_f32 %0, %1, %2" : "=v"(r) : "v"(lo), "v"(hi)); return r; }
typedef unsigned u32x2 __attribute__((ext_vector_type(2)));
constexpr float NORM_EPS = 1e-6f;
__device__ __forceinline__ float row_rstd(const float* ssq, int row) { const f32x4 s = *(const f32x4*)(ssq + (size_t)row * 4); return __builtin_amdgcn_rsqf(((s[0] + s[1]) + (s[2] + s[3])) * (1.0f / 1024.0f) + NORM_EPS); }
__device__ __forceinline__ float row_rstd_lds(const PG8_LAS unsigned char* auxb, int row_in_tile) { const f32x4 s = *(const PG8_LAS f32x4*)(auxb + row_in_tile * 16); return __builtin_amdgcn_rsqf(((s[0] + s[1]) + (s[2] + s[3])) * (1.0f / 1024.0f) + NORM_EPS); }
__device__ __forceinline__ float sigmoidf_(float x) { return __builtin_amdgcn_rcpf(1.0f + __builtin_amdgcn_exp2f(-1.4426950408889634f * x)); }

template <int MODE> struct EpiGate {
    static constexpr bool PERM = true, AFTER_DRAIN = false;
    bf16_t* O; int ldc; PG8_LAS unsigned char* aux;
    __device__ __forceinline__ void operator()(const f32x4 (&acc)[2][2][4][2], const Unit& u, int wr, int wc, int fr, int fq) const {
        const int row0 = u.pm * BM + wr * 64 + fr, ch0 = u.pn * HALF + wc * 32 + 8 * fq;
        const PG8_LAS unsigned char* auxb = aux + (u.i & 1) * AUX_BYTES; const PG8_LAS float* bl = (const PG8_LAS float*)(auxb + 4096) + wc * 32 + 8 * fq;
        f32x4 ba[2], bg[2];
#pragma unroll
        for (int n = 0; n < 2; ++n) {
            if (MODE == 0) { ba[n] = *(const PG8_LAS f32x4*)(bl + 4 * n); bg[n] = *(const PG8_LAS f32x4*)(bl + 128 + 4 * n); }
            else { ba[n] = (f32x4){0.f, 0.f, 0.f, 0.f}; bg[n] = (f32x4){0.f, 0.f, 0.f, 0.f}; } }
        float rsv[2][4];
#pragma unroll
        for (int ai = 0; ai < 2; ++ai)
#pragma unroll
            for (int m = 0; m < 4; ++m) rsv[ai][m] = row_rstd_lds(auxb, ai * HALF + wr * 64 + m * 16 + fr);
        asm volatile("" ::: "memory");
#pragma unroll
        for (int ai = 0; ai < 2; ++ai)
#pragma unroll
            for (int m = 0; m < 4; ++m) { const int row = row0 + ai * HALF + m * 16; const float rs = rsv[ai][m];
                u32x4 w;
#pragma unroll
                for (int n = 0; n < 2; ++n) { const f32x4 a = acc[ai][0][m][n] * rs + ba[n], g = acc[ai][1][m][n] * rs + bg[n]; f32x4 y;
#pragma unroll
                    for (int i = 0; i < 4; ++i) y[i] = (MODE == 0) ? a[i] * sigmoidf_(g[i]) : (a[i] * sigmoidf_(a[i])) * g[i];
                    w[2 * n] = cvt_pk_bf16(y[0], y[1]); w[2 * n + 1] = cvt_pk_bf16(y[2], y[3]); }
                *(u32x4*)(O + (size_t)row * ldc + ch0) = w; asm volatile("" ::: "memory"); }
    }
};
template <size_t OFFQ, size_t OFFK, size_t OFFV> struct EpiQKV {
    static constexpr bool PERM = true, AFTER_DRAIN = false;
    unsigned char* ws; PG8_LAS unsigned char* aux; float qscale;
    __device__ __forceinline__ void operator()(const f32x4 (&acc)[2][2][4][2], const Unit& u, int wr, int wc, int fr, int fq) const {
        const int row0 = u.pm * BM + wr * 64 + fr; int colt = u.pn * BM; const int t = colt >> 10; colt &= 1023;
        const size_t boff = (t == 0 ? OFFQ : 0) + (t == 1 ? OFFK : 0) + (t == 2 ? OFFV : 0);
        bf16_t* base = (bf16_t*)(ws + boff); const float sc = (t == 0) ? qscale : 1.0f;
        const int col0 = colt + wc * 32 + 8 * fq;
        float rsv[2][4];
#pragma unroll
        for (int ai = 0; ai < 2; ++ai)
#pragma unroll
            for (int m = 0; m < 4; ++m) rsv[ai][m] = row_rstd_lds(aux + (u.i & 1) * AUX_BYTES, ai * HALF + wr * 64 + m * 16 + fr) * sc;
        asm volatile("" ::: "memory");
#pragma unroll
        for (int ai = 0; ai < 2; ++ai)
#pragma unroll
            for (int m = 0; m < 4; ++m) { const int row = row0 + ai * HALF + m * 16; const float rs = rsv[ai][m]; bf16_t* rowp = base + (size_t)row * 1024 + col0;
#pragma unroll
                for (int bj = 0; bj < 2; ++bj) { const f32x4 v0 = acc[ai][bj][m][0] * rs, v1 = acc[ai][bj][m][1] * rs; u32x4 w;
                    w.x = cvt_pk_bf16(v0[0], v0[1]); w.y = cvt_pk_bf16(v0[2], v0[3]); w.z = cvt_pk_bf16(v1[0], v1[1]); w.w = cvt_pk_bf16(v1[2], v1[3]);
                    *(u32x4*)(rowp + bj * HALF) = w; } asm volatile("" ::: "memory"); }
    }
};
struct EpiRes {
    static constexpr bool PERM = false, AFTER_DRAIN = true;
    bf16_t* xb; float* out32; float* ssq; const float* bias;
    __device__ __forceinline__ void fused(f32x4 (&acc)[2][2][4][2], const Unit& u, int wr, int wc, int fr, int fq, PG8_LAS unsigned char* lds, int wid, int lane) const {
        const int col0 = u.pn * BM + wc * 32 + 4 * fq;
        PG8_LAS float* P = (PG8_LAS float*)lds;
        f32x4 bv[2][2];
#pragma unroll
        for (int bj = 0; bj < 2; ++bj)
#pragma unroll
            for (int n = 0; n < 2; ++n) bv[bj][n] = bias ? *(const f32x4*)(bias + col0 + bj * HALF + n * 16) : (f32x4){0.f, 0.f, 0.f, 0.f};
#pragma unroll
        for (int ai = 0; ai < 2; ++ai)
#pragma unroll
            for (int m = 0; m < 4; ++m) { const int r = ai * HALF + wr * 64 + m * 16 + fr; const size_t off = (size_t)(u.pm * BM + r) * 1024 + col0; float ss = 0.f;
#pragma unroll
                for (int bj = 0; bj < 2; ++bj)
#pragma unroll
                    for (int n = 0; n < 2; ++n) { const size_t c = off + bj * HALF + n * 16; const u32x2 bw = *(const u32x2*)(xb + c);
                        const f32x4 bs = (f32x4){__uint_as_float(bw.x << 16), __uint_as_float(bw.x & 0xffff0000u), __uint_as_float(bw.y << 16), __uint_as_float(bw.y & 0xffff0000u)};
                        const f32x4 o = bs + acc[ai][bj][m][n] + bv[bj][n];
                        if (out32) *(f32x4*)(out32 + c) = o; else { u32x2 w; w.x = cvt_pk_bf16(o[0], o[1]); w.y = cvt_pk_bf16(o[2], o[3]); *(u32x2*)(xb + c) = w; }
                        ss += (o[0] * o[0] + o[1] * o[1]) + (o[2] * o[2] + o[3] * o[3]); }
                ss += __int_as_float(__builtin_amdgcn_ds_swizzle(__float_as_int(ss), (16 << 10) | 0x1f));
                { auto rr = __builtin_amdgcn_permlane32_swap(__float_as_uint(ss), __float_as_uint(ss), false, false); ss = __uint_as_float(rr[0]) + __uint_as_float(rr[1]); }
                if (fq == 0) P[r * 4 + wc] = ss;
                if (m & 1) asm volatile("" ::: "memory"); }
        asm volatile("s_waitcnt lgkmcnt(0)" ::: "memory"); __builtin_amdgcn_s_barrier(); asm volatile("" ::: "memory");
        const int tid = wid * 64 + lane;
        if (tid < 256) { const PG8_LAS f32x4* P4 = (const PG8_LAS f32x4*)lds; const f32x4 p = P4[tid]; ssq[(size_t)(u.pm * BM + tid) * 4 + u.pn] = (p[0] + p[1]) + (p[2] + p[3]); }
    }
};

template <class Epi, class Sched, bool ALIGN_EPI = false, bool SP2 = false>
__device__ __forceinline__ void gemm_phase(PG8_LAS unsigned char* lds, const Gemm g, const Sched& S, const Epi& E, const int wave_id) {
    unsigned msk_ = ~0u; asm volatile("" : "+s"(msk_)); int tid_ = (int)__builtin_amdgcn_mbcnt_hi(msk_, __builtin_amdgcn_mbcnt_lo(msk_, 0u)); asm volatile("" : "+v"(tid_)); tid_ |= wave_id << 6;
    const int tid = tid_, wid = __builtin_amdgcn_readfirstlane(tid >> 6), lane = tid & 63, wr = wid >> 2, wc = wid & 3, fr = lane & 15, fq = lane >> 4;
    const int K = g.K, nt = K / BK;
    unsigned voffA[2], voffB[2];
#pragma unroll
    for (int i = 0; i < 2; ++i) { int R, C; stage_rc(tid * 16 + i * 8192, R, C); const int Rb = Epi::PERM ? ((R & ~31) + perm32(R & 31)) : R;
        voffA[i] = (unsigned)(R * K + C) * 2u; voffB[i] = (unsigned)(Rb * K + C) * 2u; }
    const size_t kstep = (size_t)(BK * 2);
    const size_t hstep = (size_t)HALF * K * 2;
    const size_t tstep = 2 * hstep;
    const unsigned ldsw = (unsigned)wid * 1024u;
    const int aoff = lds_byte(wr * 64 + fr, fq * 8), boff = lds_byte(wc * 32 + fr, fq * 8);
#define PG8_SA(b, h) (((b) * 2 + (h)) * HTB)
#define PG8_SB(b, h) ((4 + (b) * 2 + (h)) * HTB)
#define PG8_STAGE(bufoff, gbase, voff) do { _Pragma("unroll") for (int _i = 0; _i < 2; ++_i) \
        __builtin_amdgcn_global_load_lds((const unsigned*)((const char*)(gbase) + (voff)[_i]), (PG8_LAS unsigned*)(lds + (bufoff) + ldsw + _i * 8192), 16, 0, 0); } while (0)
#define PG8_LDA(dst, b, h) do { _Pragma("unroll") for (int m = 0; m < 4; ++m) _Pragma("unroll") for (int k = 0; k < 2; ++k) dst[m][k] = *(const PG8_LAS bf16x8*)(lds + PG8_SA(b, h) + aoff + m * 2048 + k * 1024); } while (0)
#define PG8_LDB(dst, b, h) do { _Pragma("unroll") for (int n = 0; n < 2; ++n) _Pragma("unroll") for (int k = 0; k < 2; ++k) dst[n][k] = *(const PG8_LAS bf16x8*)(lds + PG8_SB(b, h) + boff + n * 2048 + k * 1024); } while (0)
#define PG8_MMA(ai, bj, At, Bt) do { __builtin_amdgcn_s_setprio(1); _Pragma("unroll") for (int m = 0; m < 4; ++m) _Pragma("unroll") for (int n = 0; n < 2; ++n) _Pragma("unroll") for (int k = 0; k < 2; ++k) \
        acc[ai][bj][m][n] = __builtin_amdgcn_mfma_f32_16x16x32_bf16(Bt[n][k], At[m][k], acc[ai][bj][m][n], 0, 0, 0); __builtin_amdgcn_s_setprio(0); } while (0)
#define PG8_WAIT_V(n) asm volatile("s_waitcnt vmcnt(" #n ")" ::: "memory")
#define PG8_WAIT_L(n) asm volatile("s_waitcnt lgkmcnt(" #n ")" ::: "memory")
#define PG8_BAR __builtin_amdgcn_s_barrier()
#define PG8_SCHED __builtin_amdgcn_sched_barrier(0)
    Unit cur, nxt; int ui = 0;
    if (!S.next(0, cur)) return;
    f32x4 acc[2][2][4][2];
#pragma unroll
    for (int a = 0; a < 2; ++a)
#pragma unroll
        for (int b = 0; b < 2; ++b)
#pragma unroll
            for (int m = 0; m < 4; ++m)
#pragma unroll
                for (int n = 0; n < 2; ++n) acc[a][b][m][n] = (f32x4){0.f, 0.f, 0.f, 0.f};
    bf16x8 At[4][2], B0[2][2], B1[2][2];
    const char* cA = (const char*)g.A + (size_t)cur.pm * tstep; const char* cB = (const char*)g.Bt + (size_t)cur.pn * tstep;
    S.a_ready(cur);
    if constexpr (SP2) {
        PG8_STAGE(PG8_SB(0, 0), cB, voffB); PG8_STAGE(PG8_SB(0, 1), cB + hstep, voffB); PG8_STAGE(PG8_SA(0, 0), cA, voffA); PG8_STAGE(PG8_SA(0, 1), cA + hstep, voffA);
        if (wr == 1) PG8_BAR;
        PG8_WAIT_V(2); PG8_BAR;
        PG8_STAGE(PG8_SB(1, 0), cB + kstep, voffB); PG8_STAGE(PG8_SA(1, 0), cA + kstep, voffA); PG8_STAGE(PG8_SB(1, 1), cB + hstep + kstep, voffB);
        PG8_WAIT_V(6); PG8_BAR;
    } else {
        PG8_STAGE(PG8_SB(0, 0), cB, voffB); PG8_STAGE(PG8_SA(0, 0), cA, voffA); PG8_STAGE(PG8_SB(0, 1), cB + hstep, voffB); PG8_STAGE(PG8_SA(0, 1), cA + hstep, voffA);
        if (wr == 1) PG8_BAR;
        PG8_WAIT_V(4); PG8_BAR;
        PG8_STAGE(PG8_SB(1, 0), cB + kstep, voffB); PG8_STAGE(PG8_SA(1, 0), cA + kstep, voffA); PG8_STAGE(PG8_SB(1, 1), cB + hstep + kstep, voffB);
        PG8_WAIT_V(6); PG8_BAR;
    }
    for (;;) {
        const bool has_next = S.next(ui + 1, nxt);
        const char* nA = has_next ? (const char*)g.A + (size_t)nxt.pm * tstep : cA; const char* nB = has_next ? (const char*)g.Bt + (size_t)nxt.pn * tstep : cB;
        for (int t = 0; t < nt; t += 2) {
            const bool last = (t == nt - 2);
            const char* a1 = cA + (size_t)(t + 1) * kstep;
            const char* a2 = last ? nA : cA + (size_t)(t + 2) * kstep; const char* b2 = last ? nB : cB + (size_t)(t + 2) * kstep;
            const char* a3 = a2 + kstep; const char* b3 = b2 + kstep;
            if (last && has_next) S.a_ready(nxt);
            if constexpr (SP2) {
            PG8_LDB(B0, 0, 0); PG8_LDB(B1, 0, 1); PG8_SCHED; PG8_LDA(At, 0, 0); PG8_STAGE(PG8_SA(1, 1), a1 + hstep, voffA);
            PG8_WAIT_V(8); PG8_WAIT_L(0); PG8_BAR; PG8_MMA(0, 0, At, B0); PG8_MMA(0, 1, At, B1); PG8_BAR; PG8_SCHED;
            PG8_LDA(At, 0, 1); PG8_STAGE(PG8_SB(0, 0), b2, voffB); PG8_STAGE(PG8_SB(0, 1), b2 + hstep, voffB); PG8_STAGE(PG8_SA(0, 0), a2, voffA);
            PG8_WAIT_V(8); PG8_WAIT_L(0); PG8_BAR; PG8_MMA(1, 0, At, B0); PG8_MMA(1, 1, At, B1); PG8_BAR; PG8_SCHED;
            PG8_LDB(B0, 1, 0); PG8_LDB(B1, 1, 1); PG8_SCHED; PG8_LDA(At, 1, 0); PG8_STAGE(PG8_SA(0, 1), a2 + hstep, voffA);
            PG8_WAIT_V(8); PG8_WAIT_L(0); PG8_BAR; PG8_MMA(0, 0, At, B0); PG8_MMA(0, 1, At, B1); PG8_BAR; PG8_SCHED;
            PG8_LDA(At, 1, 1); PG8_STAGE(PG8_SB(1, 0), b3, voffB); PG8_STAGE(PG8_SB(1, 1), b3 + hstep, voffB); PG8_STAGE(PG8_SA(1, 0), a3, voffA);
            PG8_WAIT_V(8); PG8_WAIT_L(0); PG8_BAR; PG8_MMA(1, 0, At, B0); PG8_MMA(1, 1, At, B1); PG8_BAR; PG8_SCHED;
            } else {
            PG8_LDB(B0, 0, 0); PG8_SCHED; PG8_LDA(At, 0, 0); PG8_STAGE(PG8_SA(1, 1), a1 + hstep, voffA);
            PG8_WAIT_L(8); PG8_BAR; PG8_WAIT_L(0); PG8_MMA(0, 0, At, B0); PG8_BAR; PG8_SCHED;
            PG8_LDB(B1, 0, 1); PG8_STAGE(PG8_SB(0, 0), b2, voffB);
            PG8_BAR; PG8_WAIT_L(0); PG8_MMA(0, 1, At, B1); PG8_BAR;
            PG8_LDA(At, 0, 1); PG8_STAGE(PG8_SA(0, 0), a2, voffA);
            PG8_BAR; PG8_WAIT_L(0); PG8_MMA(1, 0, At, B0); PG8_BAR; PG8_SCHED;
            PG8_STAGE(PG8_SB(0, 1), b2 + hstep, voffB);
            PG8_WAIT_V(6); PG8_BAR; PG8_MMA(1, 1, At, B1); PG8_BAR;
            PG8_LDB(B0, 1, 0); PG8_SCHED; PG8_LDA(At, 1, 0); PG8_STAGE(PG8_SA(0, 1), a2 + hstep, voffA);
            PG8_WAIT_L(8); PG8_BAR; PG8_WAIT_L(0); PG8_MMA(0, 0, At, B0); PG8_BAR; PG8_SCHED;
            PG8_LDB(B1, 1, 1); PG8_STAGE(PG8_SB(1, 0), b3, voffB);
            PG8_BAR; PG8_WAIT_L(0); PG8_MMA(0, 1, At, B1); PG8_BAR;
            PG8_LDA(At, 1, 1); PG8_STAGE(PG8_SA(1, 0), a3, voffA);
            PG8_BAR; PG8_WAIT_L(0); PG8_MMA(1, 0, At, B0); PG8_BAR; PG8_SCHED;
            PG8_STAGE(PG8_SB(1, 1), b3 + hstep, voffB);
            PG8_WAIT_V(6); PG8_BAR; PG8_MMA(1, 1, At, B1); PG8_BAR;
            }
        }
        if constexpr (ALIGN_EPI) { if (wr == 0) PG8_BAR; }
        if constexpr (!Epi::AFTER_DRAIN) { E(acc, cur, wr, wc, fr, fq); S.done(cur); }
        if (!has_next) break;
#pragma unroll
        for (int a = 0; a < 2; ++a)
#pragma unroll
            for (int b = 0; b < 2; ++b)
#pragma unroll
                for (int m = 0; m < 4; ++m)
#pragma unroll
                    for (int n = 0; n < 2; ++n) acc[a][b][m][n] = (f32x4){0.f, 0.f, 0.f, 0.f};
        cur = nxt; cA = nA; cB = nB; ++ui;
        if constexpr (ALIGN_EPI) { if (wr == 1) PG8_BAR; }
    }
    PG8_WAIT_V(0);
    if constexpr (!ALIGN_EPI) { if (wr == 0) PG8_BAR; }
    PG8_BAR;
    if constexpr (Epi::AFTER_DRAIN) { E.fused(acc, cur, wr, wc, fr, fq, lds, wid, lane); S.done(cur); }
#undef PG8_SA
#undef PG8_SB
#undef PG8_STAGE
#undef PG8_LDA
#undef PG8_LDB
#undef PG8_MMA
#undef PG8_WAIT_V
#undef PG8_WAIT_L
#undef PG8_BAR
#undef PG8_SCHED
}
}
#define GAS __attribute__((address_space(1)))
#define LAS __attribute__((address_space(3)))
typedef unsigned short bf16;
typedef unsigned v4u __attribute__((ext_vector_type(4)));
typedef float f32x4 __attribute__((ext_vector_type(4)));
typedef short bf16x8 __attribute__((ext_vector_type(8)));
typedef GAS unsigned gu32;
typedef GAS unsigned long long gu64;
#define RLX_AGENT __ATOMIC_RELAXED, __HIP_MEMORY_SCOPE_AGENT
#define LDS_WAIT() asm volatile("s_waitcnt lgkmcnt(0)" ::: "memory")
#define VM_WAIT() asm volatile("s_waitcnt vmcnt(0)" ::: "memory")
__device__ __forceinline__ unsigned long long rt() { return __builtin_amdgcn_s_memrealtime(); }
__device__ __forceinline__ unsigned f2bf(float f) { unsigned u = __builtin_bit_cast(unsigned, f); return (u + 0x7fffu + ((u >> 16) & 1u)) >> 16; }
__device__ __forceinline__ unsigned pk2(float lo, float hi) { return f2bf(lo) | (f2bf(hi) << 16); }

#define XB_TMO      128
#define XB_XCNT(j)  (256  + 64 * (j))
#define XB_XSUB(j)  (1280 + 64 * (j))
#define XB_XGEN(j)  (2304 + 64 * (j))
#define XB_TOP      3328
#define XB_TOPGEN   3392
#define XCD_BAR_WORDS 3456
#define XB_SPIN_CAP (1u << 18)

__device__ __forceinline__ unsigned xb_ld(unsigned* p)              { return __hip_atomic_load(p, __ATOMIC_RELAXED, __HIP_MEMORY_SCOPE_AGENT); }
__device__ __forceinline__ unsigned xb_add(unsigned* p, unsigned v) { return __hip_atomic_fetch_add(p, v, __ATOMIC_RELAXED, __HIP_MEMORY_SCOPE_AGENT); }
__device__ __forceinline__ unsigned xb_xcc_id() { return (unsigned)__builtin_amdgcn_s_getreg((3 << 11) | 20) & 0xFu; }
#define XB_SPIN(cond, bar) do { unsigned _sp = 0; while (cond) { __builtin_amdgcn_s_sleep(1); \
    if ((++_sp & 255u) == 0u) { if (xb_ld(&(bar)[XB_TMO])) break; if (_sp > XB_SPIN_CAP) { atomicAdd(&(bar)[XB_TMO], 1u); break; } } } } while (0)

struct XcdBarrier {
    unsigned* bar; unsigned x;
    volatile LAS unsigned* st;
};

__device__ __forceinline__ XcdBarrier xcd_barrier_post(unsigned* bar, volatile LAS unsigned* st, const bool leader  ) {
    XcdBarrier b; b.bar = bar; b.x = xb_xcc_id(); b.st = st;
    if (leader) (void)xb_add(&bar[XB_XCNT(b.x)], 1u);
    return b;
}
__device__ __forceinline__ void xcd_barrier_complete(unsigned* bar, unsigned x, unsigned& nloc, unsigned& nx) {
    const unsigned G = gridDim.x * gridDim.y * gridDim.z;
    unsigned sum, cnt, mine, sp = 0u;
    for (;;) {
        sum = 0u; cnt = 0u; mine = 0u;
#pragma unroll
        for (unsigned j = 0; j < 16; ++j) { const unsigned c = xb_ld(&bar[XB_XCNT(j)]); sum += c; cnt += (c > 0u) ? 1u : 0u; mine = (j == x) ? c : mine; }
        if (sum == G) break;
        __builtin_amdgcn_s_sleep(1);
        if ((++sp & 255u) == 0u) { if (xb_ld(&bar[XB_TMO])) break; if (sp > XB_SPIN_CAP) { atomicAdd(&bar[XB_TMO], 1u); break; } }
    }
    nloc = mine > 0u ? mine : 1u; nx = cnt > 0u ? cnt : 1u;
}

__device__ __forceinline__ void xcd_barrier(const XcdBarrier& b, const bool leader  ) {
    asm volatile("s_waitcnt vmcnt(0)" ::: "memory");
    __syncthreads();
    if (leader) {
        unsigned* bar = b.bar;
        __builtin_amdgcn_s_waitcnt(0);
        unsigned nloc = b.st[0], nx = b.st[1];
        if (nloc == 0u) { xcd_barrier_complete(bar, b.x, nloc, nx); b.st[0] = nloc; b.st[1] = nx; }
        const unsigned old = xb_add(&bar[XB_XSUB(b.x)], 1u);
        const unsigned gen = old / nloc;
        if (old + 1u == (gen + 1u) * nloc) {
            __builtin_amdgcn_fence(__ATOMIC_RELEASE, "agent");
            asm volatile("s_waitcnt vmcnt(0)" ::: "memory");
            const unsigned og = xb_add(&bar[XB_TOP], 1u);
            const unsigned tg = og / nx;
            if (og + 1u == (tg + 1u) * nx) xb_add(&bar[XB_TOPGEN], 1u);
            else XB_SPIN(xb_ld(&bar[XB_TOPGEN]) == tg, bar);
            __builtin_amdgcn_fence(__ATOMIC_ACQUIRE, "agent");
            xb_add(&bar[XB_XGEN(b.x)], 1u);
            asm volatile("s_waitcnt vmcnt(0)" ::: "memory");
        } else {
            XB_SPIN(xb_ld(&bar[XB_XGEN(b.x)]) == gen, bar);
            __builtin_amdgcn_fence(__ATOMIC_ACQUIRE, "agent");
            asm volatile("s_waitcnt vmcnt(0)" ::: "memory");
        }
    }
    __syncthreads();
}

constexpr int NWAVES = 8;
constexpr int NB = 8, SEQ = 2048, D = 1024, M = NB * SEQ, FF = 2816, NFF2 = 2 * FF, NH = 8, CW = 31;
constexpr float EPS = 1e-6f;
constexpr float LOG2E = 1.4426950408889634f;
constexpr float QSCALE = 0.125f * LOG2E;
constexpr int N_PHASES = 22;

constexpr size_t MiB = 1u << 20;
constexpr size_t WS_CTL = 0, CTL_ZERO_BYTES = 64 * 1024;
constexpr size_t WS_SSQ = 1 * MiB;
constexpr size_t CONF_W_ELEMS = (size_t)2048 * 1024 + (size_t)1024 * 1024 + (size_t)5632 * 1024 + (size_t)1024 * 2816;
constexpr size_t ATT_W_ELEMS  = (size_t)3072 * 1024 + (size_t)1024 * 1024 + (size_t)5632 * 1024 + (size_t)1024 * 2816;
constexpr size_t CW_PW1 = 0, CW_PW2 = (size_t)2048 * 1024, CW_W13 = CW_PW2 + (size_t)1024 * 1024, CW_W2 = CW_W13 + (size_t)5632 * 1024;
constexpr size_t AW_QKV = 0, AW_WO = (size_t)3072 * 1024, AW_W13 = AW_WO + (size_t)1024 * 1024, AW_W2 = AW_W13 + (size_t)5632 * 1024;
constexpr size_t WS_WC = 2 * MiB;
constexpr size_t WS_WA = WS_WC + 2 * CONF_W_ELEMS * 2;
constexpr size_t WS_XB = WS_WA + 2 * ATT_W_ELEMS * 2;
constexpr size_t WS_V  = WS_XB + 32 * MiB;
constexpr size_t WS_R  = WS_V + 32 * MiB;
constexpr size_t WS_K  = WS_WC;
constexpr size_t WS_H = WS_R, WS_G = WS_R, WS_U = WS_R + 32 * MiB, WS_QO = WS_R, WS_O0 = WS_R + 32 * MiB;
constexpr size_t WS_END = WS_R + 96 * MiB;
static_assert(WS_WA == 47 * MiB && WS_XB == 96 * MiB && WS_R == 160 * MiB && WS_END == 256 * MiB, "d_ws map");
static_assert((size_t)M * FF * 2 <= 96 * MiB && WS_K + 32 * MiB <= WS_WA, "d_ws overlays");

constexpr int RING_OFF = 0, RING_BYTES = 131072;
constexpr int LDSCTL_OFF = RING_BYTES, MISC_OFF = LDSCTL_OFF + 320, AUX_OFF = LDSCTL_OFF + 1024;
static_assert(AUX_OFF + 2 * pg8::AUX_BYTES <= 147456, "LDS map");
constexpr int LDS_BYTES = 147456;

typedef float f32x16 __attribute__((ext_vector_type(16)));
typedef short s16x4 __attribute__((ext_vector_type(4)));
typedef float f32x2 __attribute__((ext_vector_type(2)));
typedef unsigned u32x2 __attribute__((ext_vector_type(2)));
typedef unsigned u32x4 __attribute__((ext_vector_type(4)));

struct Args { const float* in[26]; float* out; unsigned char* ws; int ph_lo, ph_hi; float lam_init2, lam_init3; };
struct Frame {
    LAS unsigned char* lds; volatile LAS unsigned* MISC; gu32* ctl;
    int tid, lane, wave, vcu, G;
};
template <int MSK> __device__ __forceinline__ float shx(float v) { return __int_as_float(__builtin_amdgcn_ds_swizzle(__float_as_int(v), (MSK << 10) | 0x1f)); }
__device__ __forceinline__ float half_sum(float v) { auto rr = __builtin_amdgcn_permlane32_swap(__float_as_uint(v), __float_as_uint(v), false, false); return __uint_as_float(rr[0]) + __uint_as_float(rr[1]); }
__device__ __forceinline__ float half_max(float v) { auto rr = __builtin_amdgcn_permlane32_swap(__float_as_uint(v), __float_as_uint(v), false, false); return fmaxf(__uint_as_float(rr[0]), __uint_as_float(rr[1])); }
__device__ __forceinline__ float half_other(float v, bool up) { auto rr = __builtin_amdgcn_permlane32_swap(__float_as_uint(v), __float_as_uint(v), false, false); return __uint_as_float(up ? rr[0] : rr[1]); }
__device__ __forceinline__ float wave_sum(float v) {
    v += shx<1>(v); v += shx<2>(v); v += shx<4>(v); v += shx<8>(v); v += shx<16>(v); return half_sum(v);
}
template <int O, int N> __device__ __forceinline__ void bfly_round(float (&v)[64], int lane) {
    const bool up = (lane & O) != 0;
#pragma unroll
    for (int i = 0; i < N; ++i) { const float send = up ? v[i] : v[i + N]; const float keep = up ? v[i + N] : v[i]; const float got = (O == 32) ? half_other(send, up) : shx<(O == 32 ? 1 : O)>(send); v[i] = keep + got; }
}
__device__ __forceinline__ int fresh_lane() { unsigned m = ~0u; asm volatile("" : "+s"(m)); int l = (int)__builtin_amdgcn_mbcnt_hi(m, __builtin_amdgcn_mbcnt_lo(m, 0u)); asm volatile("" : "+v"(l)); return l; }
__device__ __forceinline__ void refresh(Frame& F) { F.lane = fresh_lane(); F.tid = (F.wave << 6) | F.lane; }
__device__ __forceinline__ float bf_lo(unsigned v) { return __uint_as_float(v << 16); }
__device__ __forceinline__ float bf_hi(unsigned v) { return __uint_as_float(v & 0xffff0000u); }

__device__ __forceinline__ void p0_transpose_item(const float* W, int ld, int K, int nblk, const float* gain, bf16* WT, int ilv, int row_off, LAS float* scr, int item, int lane) {
    const int kb = item / nblk, nb = item % nblk, k0 = 64 * kb, n0 = 32 * nb;
    const GAS float* src = (const GAS float*)W + (size_t)(k0 + (lane >> 5)) * ld + n0 + (lane & 31);
    float v[32];
#pragma unroll
    for (int i = 0; i < 32; ++i) v[i] = src[(size_t)(2 * i) * ld];
    const int c = lane & 7;
    f32x4 g0 = (f32x4){1.f, 1.f, 1.f, 1.f}, g1 = g0;
    if (gain) { g0 = *(const GAS f32x4*)(gain + k0 + 8 * c); g1 = *(const GAS f32x4*)(gain + k0 + 8 * c + 4); }
#pragma unroll
    for (int i = 0; i < 32; ++i) scr[(2 * i + (lane >> 5)) * 33 + (lane & 31)] = v[i];
    LDS_WAIT(); asm volatile("" ::: "memory");
    const int d0 = (ilv ? (((n0 >> 7) << 8) + (n0 & 127)) : n0) + row_off;
#pragma unroll
    for (int j = 0; j < 4; ++j) { const int n = (lane >> 3) + 8 * j; const LAS float* s = scr + (8 * c) * 33 + n;
        v4u o; o.x = pk2(s[0 * 33] * g0[0], s[1 * 33] * g0[1]); o.y = pk2(s[2 * 33] * g0[2], s[3 * 33] * g0[3]); o.z = pk2(s[4 * 33] * g1[0], s[5 * 33] * g1[1]); o.w = pk2(s[6 * 33] * g1[2], s[7 * 33] * g1[3]);
        *(GAS v4u*)(WT + (size_t)(d0 + n) * K + k0 + 8 * c) = o; }
    LDS_WAIT(); asm volatile("" ::: "memory");
}
__device__ __forceinline__ void convert_layer(Frame& F, const Args& A, const int Lc, const int gw, const int NGW) {
    LAS float* scr = (LAS float*)(F.lds + RING_OFF + F.wave * 16384);
    bf16* wsb = (bf16*)A.ws;
    for (int it0 = gw; it0 < 6272; it0 += NGW) {
        const int it = __builtin_amdgcn_readfirstlane(it0);
        const int L = Lc; int r = it; int slot;
        if (r < 2048) { slot = r >> 9; r &= 511; } else { r -= 2048; slot = 4 + r / 1408; r %= 1408; }
        const float* W; int ld, K, nblk, ilv = 0, row_off = 0; const float* gain = nullptr; bf16* dst;
        bf16* wl = (L < 2) ? wsb + WS_WC / 2 + (size_t)L * CONF_W_ELEMS : wsb + WS_WA / 2 + (size_t)(L - 2) * ATT_W_ELEMS;
        if (slot >= 4) {
            if (slot == 6) { W = A.in[24] + (size_t)L * FF * D; ld = D; K = FF; nblk = D / 32; dst = wl + (L < 2 ? CW_W2 : AW_W2); }
            else { W = (slot == 4 ? A.in[22] : A.in[23]) + (size_t)L * D * FF; ld = FF; K = D; nblk = FF / 32; ilv = 1; row_off = (slot == 4) ? 0 : 128; gain = A.in[21] + L * D; dst = wl + (L < 2 ? CW_W13 : AW_W13); }
        } else if (L < 2) {
            if (slot == 3) continue;
            if (slot == 2) { W = A.in[8] + (size_t)L * D * D; ld = D; K = D; nblk = D / 32; dst = wl + CW_PW2; }
            else { W = A.in[2] + (size_t)L * D * 2 * D + (slot == 1 ? D : 0); ld = 2 * D; K = D; nblk = D / 32; ilv = 1; row_off = (slot == 1) ? 128 : 0; gain = A.in[1] + L * D; dst = wl + CW_PW1; }
        } else {
            const int j = L - 2;
            if (slot == 0) { W = A.in[14] + (size_t)j * D * D; gain = A.in[13] + j * D; dst = wl + AW_QKV; }
            else if (slot == 1) { if (j) continue; W = A.in[11]; gain = A.in[10]; dst = wl + AW_QKV; row_off = 1024; }
            else if (slot == 2) { if (j) continue; W = A.in[12]; gain = A.in[10]; dst = wl + AW_QKV; row_off = 2048; }
            else { W = A.in[20] + (size_t)j * D * D; dst = wl + AW_WO; }
            ld = D; K = D; nblk = D / 32;
        }
        p0_transpose_item(W, ld, K, nblk, gain, dst, ilv, row_off, scr, r, F.lane);
    }
}
__device__ __forceinline__ void p0_prologue(Frame& F, const Args& A) {
    refresh(F);
    const int gw = F.vcu * NWAVES + F.wave, NGW = F.G * NWAVES;
    convert_layer(F, A, 0, gw, NGW);
    const float* x = A.in[0]; bf16* XB = (bf16*)(A.ws + WS_XB); float* ssq = (float*)(A.ws + WS_SSQ);
    for (int m0 = gw * 4; m0 < M; m0 += NGW * 4) {
        f32x4 v[4][4];
#pragma unroll
        for (int q = 0; q < 4; ++q)
#pragma unroll
            for (int j = 0; j < 4; ++j) v[q][j] = *((const GAS f32x4*)(x + (size_t)(m0 + q) * D) + F.lane + 64 * j);
#pragma unroll
        for (int q = 0; q < 4; ++q) { float s = 0.f;
#pragma unroll
            for (int j = 0; j < 4; ++j) s += (v[q][j].x * v[q][j].x + v[q][j].y * v[q][j].y) + (v[q][j].z * v[q][j].z + v[q][j].w * v[q][j].w);
            s = wave_sum(s);
            GAS unsigned long long* o8 = (GAS unsigned long long*)(XB + (size_t)(m0 + q) * D) + F.lane;
#pragma unroll
            for (int j = 0; j < 4; ++j) o8[64 * j] = (unsigned long long)pk2(v[q][j].x, v[q][j].y) | ((unsigned long long)pk2(v[q][j].z, v[q][j].w) << 32);
            if (F.lane == 0) *(GAS f32x4*)(ssq + (size_t)(m0 + q) * 4) = (f32x4){s, 0.f, 0.f, 0.f}; }
    }
}
__device__ __forceinline__ void final_phase(Frame& F, float* X, const float* g) {
    refresh(F);
    const int gw = F.vcu * NWAVES + F.wave, NGW = F.G * NWAVES;
    f32x4 gv[4];
#pragma unroll
    for (int j = 0; j < 4; ++j) gv[j] = *((const GAS f32x4*)g + F.lane + 64 * j);
    for (int m0 = gw * 4; m0 < M; m0 += NGW * 4) {
        f32x4 v[4][4];
#pragma unroll
        for (int q = 0; q < 4; ++q)
#pragma unroll
            for (int j = 0; j < 4; ++j) v[q][j] = *((const GAS f32x4*)(X + (size_t)(m0 + q) * D) + F.lane + 64 * j);
#pragma unroll
        for (int q = 0; q < 4; ++q) { float s = 0.f;
#pragma unroll
            for (int j = 0; j < 4; ++j) s += (v[q][j].x * v[q][j].x + v[q][j].y * v[q][j].y) + (v[q][j].z * v[q][j].z + v[q][j].w * v[q][j].w);
            const float rs = 1.0f / sqrtf(wave_sum(s) * (1.0f / D) + EPS);
#pragma unroll
            for (int j = 0; j < 4; ++j) *((GAS f32x4*)(X + (size_t)(m0 + q) * D) + F.lane + 64 * j) = v[q][j] * rs * gv[j]; }
    }
}
__device__ __forceinline__ void conv_phase(Frame& F, const bf16* G, bf16* U, const float* dww, const float* dwb, const float* lng, const float* lnb) {
    refresh(F);
    LAS float* red = (LAS float*)(F.lds + RING_OFF);
    for (int unit = F.vcu; unit < M / 32; unit += F.G) {
        int c0 = 2 * F.tid; asm volatile("" : "+v"(c0));
        f32x2 w[CW];
#pragma unroll
        for (int j = 0; j < CW; ++j) w[j] = *(const GAS f32x2*)(dww + j * D + c0);
        const int row0 = unit * 32; const bool head = ((row0 & (SEQ - 1)) == 0);
        f32x2 acc[32];
#pragma unroll
        for (int p = 0; p < 32; ++p) acc[p] = (f32x2){0.f, 0.f};
        unsigned gin[62];
        { const GAS unsigned* gp = (const GAS unsigned*)(G + (size_t)(head ? row0 : row0 - 30) * D + c0);
#pragma unroll
          for (int i = 0; i < 62; ++i) gin[i] = gp[(size_t)(head ? (i < 30 ? 0 : i - 30) : i) * (D / 2)]; }
#pragma unroll
        for (int i = 0; i < 62; i += 2) asm volatile("" : "+v"(gin[i]), "+v"(gin[i + 1]));
        const float hmsk = head ? 0.0f : 1.0f;
#pragma unroll
        for (int i = 0; i < 62; ++i) {
            const float msk = (i < 30) ? hmsk : 1.0f;
            const unsigned v = gin[i];
            const f32x2 g = (f32x2){bf_lo(v) * msk, bf_hi(v) * msk};
#pragma unroll
            for (int p = (i > 30 ? i - 30 : 0); p <= (i < 31 ? i : 31); ++p) acc[p] += w[i - p] * g;
        }
        float v[64];
        const f32x2 bb = *(const GAS f32x2*)(dwb + c0), gg = *(const GAS f32x2*)(lng + c0), be = *(const GAS f32x2*)(lnb + c0);
#pragma unroll
        for (int p = 0; p < 32; ++p) { acc[p] += bb; v[p] = acc[p].x + acc[p].y; v[32 + p] = acc[p].x * acc[p].x + acc[p].y * acc[p].y; }
        bfly_round<32, 32>(v, F.lane); bfly_round<16, 16>(v, F.lane); bfly_round<8, 8>(v, F.lane); bfly_round<4, 4>(v, F.lane); bfly_round<2, 2>(v, F.lane); bfly_round<1, 1>(v, F.lane);
        __syncthreads();
        red[F.wave * 64 + F.lane] = v[0];
        __syncthreads();
        if (F.tid < 64) { float t = 0.f;
#pragma unroll
            for (int wv = 0; wv < 8; ++wv) t += red[wv * 64 + F.tid];
            red[512 + F.tid] = t; }
        __syncthreads();
#pragma unroll
        for (int p = 0; p < 32; ++p) {
            const float mean = red[512 + p] * (1.0f / D), var = red[512 + 32 + p] * (1.0f / D) - mean * mean, rs = 1.0f / sqrtf(fmaxf(var, 0.f) + EPS);
            const f32x2 y = (acc[p] - mean) * rs * gg + be;
            const float s0 = y.x * pg8::sigmoidf_(y.x), s1 = y.y * pg8::sigmoidf_(y.y);
            *(GAS unsigned*)(U + (size_t)(row0 + p) * D + c0) = pk2(s0, s1);
        }
    }
}
__device__ __forceinline__ int crow(int r, int hi) { return (r & 3) + 8 * (r >> 2) + 4 * hi; }
constexpr int AK_SLOT = 8192, AV_SLOT = 16384, A_KRING = 0, A_VRING = 3 * AK_SLOT, A_WSF = A_VRING + 3 * AV_SLOT;
constexpr float ATT_THR = 8.0f;
#define SBAR() __builtin_amdgcn_sched_barrier(0)
#if (PROBE_REP >> 8) & 1
#define ATT_WAIT_BAR_N(N) ATT_WAIT_BAR2(N)
#define ATT_WAIT_BAR2(N) do { if (N == 3) ATT_WAIT_BAR(6); else ATT_WAIT_BAR(4); } while (0)
#else
#define ATT_WAIT_BAR_N(N) ATT_WAIT_BAR(N)
#endif
#define ATT_WAIT_BAR(N) asm volatile("s_waitcnt vmcnt(" #N ") lgkmcnt(0)\n\ts_barrier" ::: "memory")
__device__ __forceinline__ void glds16s(const void* sbase, unsigned voff, unsigned lds_dst) {
    unsigned keep; asm volatile("s_mov_b32 %0, m0\n\ts_mov_b32 m0, %2\n\ts_nop 0\n\tglobal_load_lds_dwordx4 %1, %3\n\ts_mov_b32 m0, %0" : "=&s"(keep) : "v"(voff), "s"(lds_dst), "s"(sbase) : "memory"); }
__device__ __forceinline__ float att_rowmax(const f32x16& p0, const f32x16& p1) {
    float a = fmaxf(fmaxf(p0[0], p0[1]), p1[0]), b = fmaxf(fmaxf(p0[2], p0[3]), p1[1]); a = fmaxf(fmaxf(a, p1[2]), p1[3]);
#pragma unroll
    for (int r = 4; r < 16; r += 4) { a = fmaxf(fmaxf(a, p0[r]), p0[r + 1]); b = fmaxf(fmaxf(b, p0[r + 2]), p0[r + 3]); a = fmaxf(fmaxf(a, p1[r]), p1[r + 1]); b = fmaxf(fmaxf(b, p1[r + 2]), p1[r + 3]); }
    return half_max(fmaxf(a, b));
}
__device__ __forceinline__ void att_mask(f32x16& p0, f32x16& p1, int kb, int tq) {
#pragma unroll
    for (int r = 0; r < 16; ++r) { const int kv = kb + (r & 3) + 8 * (r >> 2); if (kv > tq) p0[r] = -INFINITY; if (kv + 32 > tq) p1[r] = -INFINITY; }
}
__device__ __forceinline__ void att_qk(f32x16& p0, f32x16& p1, const LAS unsigned char* kp, const bf16x8 (&qr)[4], const f32x16& cin) {
    bf16x8 kf[8];
#pragma unroll
    for (int d0 = 0; d0 < 4; ++d0) { kf[2 * d0] = *(const LAS bf16x8*)(kp + d0 * 2048); kf[2 * d0 + 1] = *(const LAS bf16x8*)(kp + d0 * 2048 + 512); }
    SBAR();
#pragma unroll
    for (int d0 = 0; d0 < 4; ++d0) {
        p0 = __builtin_amdgcn_mfma_f32_32x32x16_bf16(kf[2 * d0], qr[d0], d0 == 0 ? cin : p0, 0, 0, 0); p1 = __builtin_amdgcn_mfma_f32_32x32x16_bf16(kf[2 * d0 + 1], qr[d0], d0 == 0 ? cin : p1, 0, 0, 0); }
}
__device__ __forceinline__ void att_pv(f32x16 (&o)[4], const LAS unsigned char* vp, const u32x4 (&pw)[4]) {
#pragma unroll
    for (int d0 = 0; d0 < 4; ++d0)
#pragma unroll
        for (int ks = 0; ks < 4; ++ks) {
            const s16x4 lo = __builtin_bit_cast(s16x4, __builtin_amdgcn_ds_read_tr16_b64_v4i16((LAS s16x4*)(vp + d0 * 4096 + ks * 1024)));
            const s16x4 hh = __builtin_bit_cast(s16x4, __builtin_amdgcn_ds_read_tr16_b64_v4i16((LAS s16x4*)(vp + d0 * 4096 + ks * 1024 + 512)));
            const bf16x8 vf = (bf16x8){lo[0], lo[1], lo[2], lo[3], hh[0], hh[1], hh[2], hh[3]};
            o[d0] = __builtin_amdgcn_mfma_f32_32x32x16_bf16(__builtin_bit_cast(bf16x8, pw[ks]), vf, o[d0], 0, 0, 0); }
}
typedef __bf16 bf16x2_t __attribute__((ext_vector_type(2)));
__device__ __forceinline__ unsigned cvtpk_s(float lo, float hi) { f32x2 v = {lo, hi}; return __builtin_bit_cast(unsigned, __builtin_convertvector(v, bf16x2_t)); }
__device__ __forceinline__ void att_mask_arith(f32x16& p0, f32x16& p1, int kb, int tq) {
    const float x = (float)(kb - tq);
#pragma unroll
    for (int r = 0; r < 16; ++r) { const float kr = (float)((r & 3) + 8 * (r >> 2));
        p0[r] = __builtin_fmaf(fmaxf(x + kr, 0.f), -1e30f, p0[r]); p1[r] = __builtin_fmaf(fmaxf(x + (kr + 32.0f), 0.f), -1e30f, p1[r]); }
}
__device__ __forceinline__ s16x4 att_vtr(const LAS unsigned char* p) { return __builtin_bit_cast(s16x4, __builtin_amdgcn_ds_read_tr16_b64_v4i16((LAS s16x4*)p)); }
template <bool DOEXP> __device__ __forceinline__ float att_pv_exp(f32x16 (&o)[4], const LAS unsigned char* vp, const u32x4 (&pwi)[4], f32x16& p0, f32x16& p1, u32x4 (&pwo)[4]) {
    s16x4 vl[8], vh[8]; float ls = 0.f;
#define VRD(i) do { vl[(i) & 7] = att_vtr(vp + ((i) & 3) * 4096 + ((i) >> 2) * 1024); vh[(i) & 7] = att_vtr(vp + ((i) & 3) * 4096 + ((i) >> 2) * 1024 + 512); } while (0)
#define VFR(i) (bf16x8){vl[(i) & 7][0], vl[(i) & 7][1], vl[(i) & 7][2], vl[(i) & 7][3], vh[(i) & 7][0], vh[(i) & 7][1], vh[(i) & 7][2], vh[(i) & 7][3]}
#ifndef ATT_PF
#define ATT_PF 4
#endif
#pragma unroll
    for (int i = 0; i < ATT_PF; ++i) VRD(i);
    SBAR();
#pragma unroll
    for (int i = 0; i < 16; ++i) {
        o[i & 3] = __builtin_amdgcn_mfma_f32_32x32x16_bf16(__builtin_bit_cast(bf16x8, pwi[i >> 2]), VFR(i), o[i & 3], 0, 0, 0);
        if (i + ATT_PF < 16) VRD(i + ATT_PF);
        if (DOEXP) { float e0, e1;
            if (i < 8) { e0 = __builtin_amdgcn_exp2f(p0[2 * i]); e1 = __builtin_amdgcn_exp2f(p0[2 * i + 1]); } else { e0 = __builtin_amdgcn_exp2f(p1[2 * i - 16]); e1 = __builtin_amdgcn_exp2f(p1[2 * i - 15]); }
#if (PROBE_REP >> 9) & 1
            { float x0 = (i < 8) ? p0[2 * i] : p1[2 * i - 16], x1 = (i < 8) ? p0[2 * i + 1] : p1[2 * i - 15]; asm volatile("" : "+v"(x0), "+v"(x1)); float d0_ = __builtin_amdgcn_exp2f(x0), d1_ = __builtin_amdgcn_exp2f(x1); float s_ = d0_ + d1_; unsigned c_ = cvtpk_s(d0_, d1_); asm volatile("" :: "v"(s_), "v"(c_)); }
#endif
            ls += e0; ls += e1; pwo[i >> 2][i & 3] = cvtpk_s(e0, e1);
            asm volatile("" : "+v"(ls), "+v"(pwo[i >> 2][i & 3])); }
        SBAR();
    }
#undef VRD
#undef VFR
    return ls;
}
__device__ __forceinline__ void attn_unit(Frame& F, int b, int h, int qb, const bf16* Qb, const bf16* Kb, const bf16* Vb, bf16* Ob, float* O0, float lam, float lam_init, const float* subg, const bool do_store = true) {
    const int lane = F.lane, r32 = lane & 31, hi = lane >> 5, wid = F.wave;
    LAS unsigned char* lds = F.lds + RING_OFF;
    const unsigned lds0 = (unsigned)(uintptr_t)lds;
    LAS float* wsf = (LAS float*)(lds + A_WSF) + wid * 64;
    const size_t rowbase = (size_t)b * SEQ; const int q0 = qb * 256, NT = 4 * (qb + 1);
    const int tq = q0 + 32 * wid + r32;
    const float sl2 = LOG2E * __builtin_amdgcn_exp2f(-(float)(h + 1));
    const int unit_lin = (b * NH + h) * 8 + qb;
    const LAS unsigned char* kp0 = lds + A_KRING + hi * 1024 + r32 * 16;
    const LAS unsigned char* vp0 = lds + A_VRING + ((lane >> 4) & 1) * 32 + (lane & 3) * 8 + (4 * hi + ((lane & 15) >> 2)) * 64;
    const unsigned kdst = lds0 + A_KRING + wid * 1024, vdst = lds0 + A_VRING + wid * 1024;
    const int wdiag = wid >> 1;
#pragma unroll 1
    for (int c = 0; c < 2; ++c) {
        const bf16* Qw = Qb + (rowbase + q0 + wid * 32) * D + (2 * h + c) * 64;
        const bf16* kbase = Kb + rowbase * D + (2 * h + c) * 64 + wid * 8;
        const bf16* vbase = Vb + (rowbase + 16 * (wid & 3)) * D + h * 128 + (wid >> 2) * 32;
        const unsigned kvoff = (unsigned)lane * (D * 2), vvoff = (unsigned)(lane >> 2) * (D * 2) + (unsigned)(lane & 3) * 16;
#if (PROBE_REP >> 8) & 1
#define DMA_K(t, slot) do { glds16s(kbase + (size_t)(t) * 64 * D, kvoff, (unsigned)__builtin_amdgcn_readfirstlane(kdst + (slot) * AK_SLOT)); glds16s(kbase + (size_t)(t) * 64 * D, kvoff, (unsigned)__builtin_amdgcn_readfirstlane(kdst + (slot) * AK_SLOT)); } while (0)
#else
#define DMA_K(t, slot) glds16s(kbase + (size_t)(t) * 64 * D, kvoff, (unsigned)__builtin_amdgcn_readfirstlane(kdst + (slot) * AK_SLOT))
#endif
#if (PROBE_REP >> 8) & 1
#define DMA_V(t, slot) do { glds16s(vbase + (size_t)(t) * 64 * D, vvoff, (unsigned)__builtin_amdgcn_readfirstlane(vdst + (slot) * AV_SLOT)); \
                            glds16s(vbase + 64 + (size_t)(t) * 64 * D, vvoff, (unsigned)__builtin_amdgcn_readfirstlane(vdst + (slot) * AV_SLOT + 8192)); \
                            glds16s(vbase + (size_t)(t) * 64 * D, vvoff, (unsigned)__builtin_amdgcn_readfirstlane(vdst + (slot) * AV_SLOT)); \
                            glds16s(vbase + 64 + (size_t)(t) * 64 * D, vvoff, (unsigned)__builtin_amdgcn_readfirstlane(vdst + (slot) * AV_SLOT + 8192)); } while (0)
#else
#define DMA_V(t, slot) do { glds16s(vbase + (size_t)(t) * 64 * D, vvoff, (unsigned)__builtin_amdgcn_readfirstlane(vdst + (slot) * AV_SLOT)); \
                            glds16s(vbase + 64 + (size_t)(t) * 64 * D, vvoff, (unsigned)__builtin_amdgcn_readfirstlane(vdst + (slot) * AV_SLOT + 8192)); } while (0)
#endif
        DMA_K(0, 0); DMA_V(0, 0); DMA_K(1, 1);
        bf16x8 qr[4];
#pragma unroll
        for (int d0 = 0; d0 < 4; ++d0) qr[d0] = *(const GAS bf16x8*)(Qw + (size_t)r32 * D + d0 * 16 + hi * 8);
        f32x16 o[4];
#pragma unroll
        for (int d0 = 0; d0 < 4; ++d0) o[d0] = (f32x16){};
        float mref, l_run = 0.f; u32x4 pwA[4], pwB[4]; f32x16 p0, p1;
        ATT_WAIT_BAR_N(3);
        DMA_K(2, 2); DMA_V(1, 1);
        {
            const f32x16 z = (f32x16){};
            att_qk(p0, p1, kp0, qr, z);
            if (NT == 4 && wdiag == 0) att_mask_arith(p0, p1, 4 * hi, tq);
            mref = att_rowmax(p0, p1);
            const float cb = sl2 * (float)(4 * hi - tq) - mref;
#pragma unroll
            for (int r = 0; r < 16; ++r) { const float kr = (float)((r & 3) + 8 * (r >> 2)); p0[r] = __builtin_fmaf(sl2, kr, p0[r]) + cb; p1[r] = __builtin_fmaf(sl2, kr + 32.0f, p1[r]) + cb; }
#pragma unroll
            for (int i = 0; i < 16; ++i) { float e0, e1;
                if (i < 8) { e0 = __builtin_amdgcn_exp2f(p0[2 * i]); e1 = __builtin_amdgcn_exp2f(p0[2 * i + 1]); } else { e0 = __builtin_amdgcn_exp2f(p1[2 * i - 16]); e1 = __builtin_amdgcn_exp2f(p1[2 * i - 15]); }
                l_run += e0; l_run += e1; pwA[i >> 2][i & 3] = cvtpk_s(e0, e1); }
        }
        ATT_WAIT_BAR_N(3);
        int sp = 2, sc = 0, sn = 1;
#define ATT_STEP(t, PWI, PWO) do { \
            sp = sc; sc = sn; sn = (sn == 2) ? 0 : sn + 1; \
            if ((t) + 2 < NT) DMA_K((t) + 2, sp); \
            if ((t) + 1 < NT) DMA_V((t) + 1, sn); \
            { const float cv = sl2 * (float)(64 * (t) + 4 * hi - tq) - mref; f32x16 cin; \
              _Pragma("unroll") for (int r = 0; r < 16; ++r) cin[r] = cv; \
              att_qk(p0, p1, kp0 + sc * AK_SLOT, qr, cin); } \
            _Pragma("unroll") for (int r = 0; r < 16; ++r) { const float kr = (float)((r & 3) + 8 * (r >> 2)); p0[r] = __builtin_fmaf(sl2, kr, p0[r]); p1[r] = __builtin_fmaf(sl2, kr + 32.0f, p1[r]); } \
            if ((t) >= NT - 4 && (t) - (NT - 4) >= wdiag) att_mask_arith(p0, p1, 64 * (t) + 4 * hi, tq); \
            const float rm = att_rowmax(p0, p1); \
            if (__builtin_expect(__any(rm > ATT_THR), 0)) { \
                const float dl = fmaxf(rm, 0.f), fs = __builtin_amdgcn_exp2f(-dl); mref += dl; l_run *= fs; \
                _Pragma("unroll") for (int r = 0; r < 16; ++r) { p0[r] -= dl; p1[r] -= dl; } \
                _Pragma("unroll") for (int ks = 0; ks < 4; ++ks) _Pragma("unroll") for (int k = 0; k < 4; ++k) { const unsigned wv = PWI[ks][k]; PWI[ks][k] = cvtpk_s(bf_lo(wv) * fs, bf_hi(wv) * fs); } \
                if (hi == 0) wsf[r32] = fs; \
                _Pragma("unroll") for (int r = 0; r < 16; ++r) { const float fr_ = wsf[crow(r, hi)]; _Pragma("unroll") for (int d0 = 0; d0 < 4; ++d0) o[d0][r] *= fr_; } \
            } \
            SBAR(); \
            l_run += att_pv_exp<true>(o, vp0 + sp * AV_SLOT, PWI, p0, p1, PWO); \
            if ((t) + 2 < NT) ATT_WAIT_BAR_N(3); else if ((t) + 1 < NT) ATT_WAIT_BAR_N(2); else ATT_WAIT_BAR(0); \
        } while (0)
        int t = 1;
#pragma unroll 1
        for (; t + 1 < NT; t += 2) { ATT_STEP(t, pwA, pwB); ATT_STEP(t + 1, pwB, pwA); }
        ATT_STEP(t, pwA, pwB);
#undef ATT_STEP
        (void)att_pv_exp<false>(o, vp0 + sc * AV_SLOT, pwB, p0, p1, pwA);
        asm volatile("s_waitcnt lgkmcnt(0)\n\ts_barrier" ::: "memory");
#undef DMA_K
#undef DMA_V
        l_run = half_sum(l_run);
        if (hi == 0) wsf[32 + r32] = l_run;
        float rl[16];
#pragma unroll
        for (int r = 0; r < 16; ++r) rl[r] = 1.0f / wsf[32 + crow(r, hi)];
        int ln_ = lane; asm volatile("" : "+v"(ln_));
        float* park = O0 + ((size_t)(unit_lin * 8 + wid) * 64 + ln_) * 64;
        if (c == 0) {
#pragma unroll
            for (int d0 = 0; d0 < 4; ++d0)
#pragma unroll
                for (int q = 0; q < 4; ++q) *(GAS f32x4*)(park + d0 * 16 + q * 4) = (f32x4){o[d0][4 * q] * rl[4 * q], o[d0][4 * q + 1] * rl[4 * q + 1], o[d0][4 * q + 2] * rl[4 * q + 2], o[d0][4 * q + 3] * rl[4 * q + 3]};
        } else {
            asm volatile("s_waitcnt vmcnt(0)" ::: "memory");
            float ss[16];
#pragma unroll
            for (int r = 0; r < 16; ++r) ss[r] = 0.f;
#pragma unroll
            for (int d0 = 0; d0 < 4; ++d0)
#pragma unroll
                for (int q = 0; q < 4; ++q) { const f32x4 pk = *(const GAS f32x4*)(park + d0 * 16 + q * 4);
#pragma unroll
                    for (int i = 0; i < 4; ++i) { const int r = 4 * q + i; const float v = pk[i] - lam * (o[d0][r] * rl[r]); o[d0][r] = v; ss[r] += v * v; } }
#pragma unroll
            for (int r = 0; r < 16; ++r) {
                ss[r] += shx<1>(ss[r]); ss[r] += shx<2>(ss[r]); ss[r] += shx<4>(ss[r]); ss[r] += shx<8>(ss[r]); ss[r] += shx<16>(ss[r]);
                ss[r] = (1.0f - lam_init) / sqrtf(ss[r] * (1.0f / 128.0f) + EPS); }
            float gsub[4];
#pragma unroll
            for (int d0 = 0; d0 < 4; ++d0) gsub[d0] = subg[32 * d0 + r32];
            bf16* Ow = Ob + (rowbase + q0 + wid * 32 + 4 * hi + 2) * D + h * 128 + r32;
            if (do_store)
#pragma unroll
            for (int g = 0; g < 4; ++g) { asm volatile("" : "+v"(Ow));
#pragma unroll
                for (int i = 0; i < 4; ++i)
#pragma unroll
                    for (int d0 = 0; d0 < 4; ++d0) Ow[(i - 2) * D + 32 * d0] = (bf16)f2bf(o[d0][4 * g + i] * ss[4 * g + i] * gsub[d0]);
                Ow += 8 * D; }
        }
        __syncthreads();
    }
}
__device__ __forceinline__ void attn_phase(Frame& F, const Args& A, int j, float lam_init) {
    refresh(F);
    const bf16* Qb = (const bf16*)(A.ws + WS_QO); const bf16* Kb = (const bf16*)(A.ws + WS_K); const bf16* Vb = (const bf16*)(A.ws + WS_V);
    bf16* Ob = (bf16*)(A.ws + WS_QO); float* O0 = (float*)(A.ws + WS_O0);
    const float a = wave_sum(A.in[15][j * 64 + F.lane] * A.in[16][j * 64 + F.lane]), b2 = wave_sum(A.in[17][j * 64 + F.lane] * A.in[18][j * 64 + F.lane]);
    const float lam = expf(a) - expf(b2) + lam_init;
    const float* subg = A.in[19] + j * 128;
    for (int w = 2 * F.vcu; w < NB * NH * 8; w += 2 * F.G) {
#pragma unroll 1
        for (int e = 0; e < 2; ++e) { const int ww = w + e, bh = ww >> 3, k = ww & 7, qb = (k & 1) ? 7 - (k >> 1) : (k >> 1);
#if (PROBE_REP >> 4) & 1
            attn_unit(F, bh >> 3, bh & 7, qb, Qb, Kb, Vb, Ob, O0, lam, lam_init, subg, false);
#endif
            attn_unit(F, bh >> 3, bh & 7, qb, Qb, Kb, Vb, Ob, O0, lam, lam_init, subg); }
    }
}

__global__ void __launch_bounds__(NWAVES * 64, 2) yoco_fwd(Args args) {
    extern __shared__ __attribute__((aligned(16))) unsigned char lds_raw[];
    Frame F;
    F.lds = (LAS unsigned char*)lds_raw;
    F.MISC = (volatile LAS unsigned*)(F.lds + MISC_OFF);
    F.tid = threadIdx.x; F.lane = F.tid & 63; F.wave = __builtin_amdgcn_readfirstlane(F.tid >> 6);
    F.G = gridDim.x; { const int bx = blockIdx.x; F.vcu = (F.G % 8 == 0) ? (bx % 8) * (F.G / 8) + bx / 8 : bx; }
    unsigned char* ws = args.ws;
    F.ctl = (gu32*)(ws + WS_CTL);
    for (int u = F.tid; u < (LDS_BYTES - LDSCTL_OFF) / 4; u += NWAVES * 64) ((LAS unsigned*)(F.lds + LDSCTL_OFF))[u] = 0u;
    __syncthreads();
    const int lo = args.ph_lo, hi = args.ph_hi;
    XcdBarrier bar; bar.bar = (unsigned*)F.ctl; bar.x = 0; bar.st = nullptr;
    if (hi - lo > 1) bar = xcd_barrier_post((unsigned*)F.ctl, F.MISC + 8, F.tid == 0);

    bf16* wsb = (bf16*)ws;
    bf16* XB = (bf16*)(ws + WS_XB); float* SSQ = (float*)(ws + WS_SSQ); float* X = args.out;
#pragma unroll 1
    for (int ph = lo; ph < hi; ++ph) {
#if PROBE_REP
      int kind_ = 0; if (ph == 0) kind_ = 0; else if (ph == N_PHASES - 1) kind_ = 15; else { const int L_ = (ph - 1) / 5, k_ = (ph - 1) % 5; kind_ = (k_ == 0) ? (L_ < 2 ? 1 : 3) : (k_ == 1) ? (L_ < 2 ? 2 : 4) : (k_ == 3) ? 5 : 15; }
      const int reps_ = 1 + ((kind_ != 4) && ((PROBE_REP >> kind_) & 1));
#pragma unroll 1
      for (int rep_ = 0; rep_ < reps_; ++rep_) {
        if (rep_) xcd_barrier(bar, F.wave == 0 && fresh_lane() == 0);
#endif
        if (ph == 0) p0_prologue(F, args);
        else if (ph == N_PHASES - 1) final_phase(F, X, args.in[25]);
        else {
            const int L = (ph - 1) / 5, k = (ph - 1) % 5;
            bf16* wl = (L < 2) ? wsb + WS_WC / 2 + (size_t)L * CONF_W_ELEMS : wsb + WS_WA / 2 + (size_t)(L - 2) * ATT_W_ELEMS;
            if (k == 0 && L < 2) {
                refresh(F);
                pg8::Gemm g{XB, wl + CW_PW1, M, 2 * D, D}; pg8::AuxOrder S; S.init(M, 2 * D, F.G, (int)blockIdx.x); S.ssq = SSQ; S.bias = args.in[3] + L * 2 * D; S.aux = F.lds + AUX_OFF; S.wid = F.wave; S.lane = F.lane;
                pg8::EpiGate<0> E{(bf16*)(ws + WS_G), D, F.lds + AUX_OFF};
                pg8::gemm_phase<pg8::EpiGate<0>, pg8::AuxOrder, true, true>(F.lds + RING_OFF, g, S, E, F.wave);
            } else if (k == 0) {
                const int N = (L == 2) ? 3 * D : D;
                refresh(F);
                pg8::Gemm g{XB, wl + AW_QKV, M, N, D}; pg8::AuxOrder S; S.init(M, N, F.G, (int)blockIdx.x); S.ssq = SSQ; S.bias = nullptr; S.aux = F.lds + AUX_OFF; S.wid = F.wave; S.lane = F.lane;
                typedef pg8::EpiQKV<WS_QO, WS_K, WS_V> EQ; EQ E{ws, F.lds + AUX_OFF, QSCALE};
                pg8::gemm_phase<EQ, pg8::AuxOrder, true, true>(F.lds + RING_OFF, g, S, E, F.wave);
            } else if (k == 1 && L < 2) {
                conv_phase(F, (const bf16*)(ws + WS_G), (bf16*)(ws + WS_U), args.in[4] + L * CW * D, args.in[5] + L * D, args.in[6] + L * D, args.in[7] + L * D);
            } else if (k == 1) {
                attn_phase(F, args, L - 2, L == 2 ? args.lam_init2 : args.lam_init3);
            } else if (k == 3) {
                refresh(F);
                pg8::Gemm g{XB, wl + (L < 2 ? CW_W13 : AW_W13), M, NFF2, D}; pg8::AuxOrder S; S.init(M, NFF2, F.G, (int)blockIdx.x); S.ssq = SSQ; S.bias = nullptr; S.aux = F.lds + AUX_OFF; S.wid = F.wave; S.lane = F.lane;
                pg8::EpiGate<1> E{(bf16*)(ws + WS_H), FF, F.lds + AUX_OFF};
                pg8::gemm_phase<pg8::EpiGate<1>, pg8::AuxOrder, true, true>(F.lds + RING_OFF, g, S, E, F.wave);
                { pg8::Unit u_; const int nfull = (M / 256) * (NFF2 / 256) / F.G, nrem = (M / 256) * (NFF2 / 256) % F.G;
                  if (L < 3 && nrem && !S.next(nfull, u_)) { refresh(F); convert_layer(F, args, L + 1, ((int)blockIdx.x - nrem) * NWAVES + F.wave, (F.G - nrem) * NWAVES); }
                  else if (L < 3 && !nrem) { refresh(F); convert_layer(F, args, L + 1, F.vcu * NWAVES + F.wave, F.G * NWAVES); } }
            } else {
                const bf16* Aop; const bf16* Bop; int K; const float* bias = nullptr;
                if (k == 4) { Aop = (const bf16*)(ws + WS_H); Bop = wl + (L < 2 ? CW_W2 : AW_W2); K = FF; }
                else if (L < 2) { Aop = (const bf16*)(ws + WS_U); Bop = wl + CW_PW2; K = D; bias = args.in[9] + L * D; }
                else { Aop = (const bf16*)(ws + WS_QO); Bop = wl + AW_WO; K = D; }
                pg8::Gemm g{Aop, Bop, M, D, K}; pg8::StaticOrder S; S.init(M, D, F.G, (int)blockIdx.x);
                pg8::EpiRes E{XB, (L == 3 && k == 4) ? X : nullptr, SSQ, bias};
                if (F.G == 256) pg8::gemm_phase<pg8::EpiRes, pg8::StaticOrder, false, true>(F.lds + RING_OFF, g, S, E, F.wave);
            }
        }
#if PROBE_REP
      }
      if ((PROBE_REP >> 6) & 1) { if (ph + 1 < hi) xcd_barrier(bar, F.wave == 0 && fresh_lane() == 0); }
#endif
        if (ph + 1 < hi) xcd_barrier(bar, F.wave == 0 && fresh_lane() == 0);
    }
}

#ifndef MK_ONE_LAUNCH
#define MK_ONE_LAUNCH 0
#endif
extern "C" void kernel_launch(void* const* d_in, const int* in_sizes, int n_in, void* d_out, int out_size, void* d_ws, size_t ws_size, hipStream_t stream) {
    static int grid = 0;
    if (grid == 0) {
        if (n_in != 26 || in_sizes[0] != M * D || out_size != M * D || ws_size < WS_END) { fprintf(stderr, "kernel_launch: unexpected shapes (n_in %d, in0 %d, out %d, ws %zu); nothing launched\n", n_in, n_in > 0 ? in_sizes[0] : -1, out_size, ws_size); grid = -1; return; }
        int dev = 0, cus = 0, per_cu = 0;
        if (hipGetDevice(&dev) != hipSuccess || hipDeviceGetAttribute(&cus, hipDeviceAttributeMultiprocessorCount, dev) != hipSuccess) { grid = -1; return; }
        if (hipFuncSetAttribute((const void*)yoco_fwd, hipFuncAttributeMaxDynamicSharedMemorySize, LDS_BYTES) != hipSuccess) { fprintf(stderr, "kernel_launch: hipFuncSetAttribute failed\n"); grid = -1; return; }
        if (hipOccupancyMaxActiveBlocksPerMultiprocessor(&per_cu, (const void*)yoco_fwd, NWAVES * 64, LDS_BYTES) != hipSuccess || per_cu < 1) { fprintf(stderr, "kernel_launch: occupancy query says %d blocks per CU\n", per_cu); }
        (void)hipGetLastError();
        grid = cus;
        if (grid != 256) fprintf(stderr, "kernel_launch: %d CUs; the residual GEMM phases need exactly 256 workgroups\n", grid);
    }
    if (grid < 0) return;
    if (hipMemsetAsync((char*)d_ws + WS_CTL, 0, CTL_ZERO_BYTES, stream) != hipSuccess) return;
    Args a{};
    for (int i = 0; i < 26; ++i) a.in[i] = (const float*)d_in[i];
    a.out = (float*)d_out; a.ws = (unsigned char*)d_ws;
    a.lam_init2 = (float)(0.8 - 0.6 * exp(-0.3 * 2.0)); a.lam_init3 = (float)(0.8 - 0.6 * exp(-0.3 * 3.0));
#if MK_ONE_LAUNCH
    a.ph_lo = 0; a.ph_hi = N_PHASES;
    hipLaunchKernelGGL(yoco_fwd, dim3(grid), dim3(NWAVES * 64), LDS_BYTES, stream, a);
#else
    for (int p = 0; p < N_PHASES; ++p) { a.ph_lo = p; a.ph_hi = p + 1; hipLaunchKernelGGL(yoco_fwd, dim3(grid), dim3(NWAVES * 64), LDS_BYTES, stream, a); }
#endif
}
```
